# Optimizing an MI355X kernel written in HIP

```python
import math
import jax
import jax.numpy as jnp
from jax import lax
import numpy as np

D_MODEL = 1024
BATCH = 8
SEQ = 2048
DEPTH = 2
DEC_BATCH = 128
DEC_SEQ = 1
PAST_LEN = 16384
PAGE_SIZE = 128

MIX_WIDTH = D_MODEL
BRANCH = MIX_WIDTH // 4
S5_CH = 16
S5_GROUPS = BRANCH // S5_CH
S5_STATE = 64
HG_HEADS = 4
HG_DK = BRANCH // HG_HEADS
HG_DV = BRANCH // HG_HEADS
GLA_HEADS = 4
GLA_DK = BRANCH // (2 * GLA_HEADS)
GLA_DV = BRANCH // GLA_HEADS
GLA_LOWRANK = 16
GLA_TAU = 16.0
RET_HEADS = 4
RET_DK = BRANCH // (2 * RET_HEADS)
RET_DV = BRANCH // RET_HEADS
GATED_CHUNK = 16
RET_CHUNK = 64
ROPE_BASE = 10000.0
EPS = 1e-6
SPLIT_WIDTHS = (BRANCH, BRANCH,
                BRANCH, BRANCH, BRANCH, BRANCH,
                GLA_HEADS * GLA_DK, GLA_HEADS * GLA_DK, BRANCH, GLA_LOWRANK, BRANCH,
                RET_HEADS * RET_DK, RET_HEADS * RET_DK, BRANCH, BRANCH)
N_IN = sum(SPLIT_WIDTHS)

kernel_name = 'hybrid_s5_hgrn2_gla_retnet_step'


def rmsnorm(x, w):
    xf = x.astype(jnp.float32)
    y = xf * lax.rsqrt(jnp.mean(xf * xf, axis=-1, keepdims=True) + EPS)
    return (y * w.astype(jnp.float32)).astype(x.dtype)


def split_heads(t, n_heads):
    b, l, w = t.shape
    return t.reshape(b, l, n_heads, w // n_heads).transpose(0, 2, 1, 3)


def merge_heads(t):
    b, h, l, d = t.shape
    return t.transpose(0, 2, 1, 3).reshape(b, l, h * d)


def head_rmsnorm(o, g):
    h, d = o.shape[1], o.shape[3]
    y = o * lax.rsqrt(jnp.mean(o * o, axis=-1, keepdims=True) + EPS)
    return y * g.astype(jnp.float32).reshape(h, 1, d)


def head_layernorm(o, g):
    h, d = o.shape[1], o.shape[3]
    c = o - jnp.mean(o, axis=-1, keepdims=True)
    y = c * lax.rsqrt(jnp.mean(c * c, axis=-1, keepdims=True) + EPS)
    return y * g.astype(jnp.float32).reshape(h, 1, d)


def rotary(t, pos):
    half = t.shape[-1] // 2
    inv = ROPE_BASE ** (-jnp.arange(half, dtype=jnp.float32) / half)
    ang = pos.astype(jnp.float32)[:, None] * inv[None, :]
    cos, sin = jnp.cos(ang), jnp.sin(ang)
    t1, t2 = t[..., :half], t[..., half:]
    return jnp.concatenate([t1 * cos - t2 * sin, t1 * sin + t2 * cos], axis=-1)


def s5_branch(u, s0_re, s0_im, lam_re, lam_im, log_step, b_re, b_im, c_re, c_im, d_skip, w_glu):
    bn, l, _ = u.shape
    uf = u.reshape(bn, l, S5_GROUPS, S5_CH)
    lr = lam_re.astype(jnp.float32)
    li = lam_im.astype(jnp.float32)
    step = jnp.exp(log_step.astype(jnp.float32))[:, None]
    mag = jnp.exp(lr * step)
    ab_re = mag * jnp.cos(li * step)
    ab_im = mag * jnp.sin(li * step)
    den = lr * lr + li * li
    nr = ab_re - 1.0
    f_re = (nr * lr + ab_im * li) / den
    f_im = (ab_im * lr - nr * li) / den
    br = b_re.astype(jnp.float32)
    bi = b_im.astype(jnp.float32)
    bb_re = f_re[..., None] * br - f_im[..., None] * bi
    bb_im = f_re[..., None] * bi + f_im[..., None] * br
    bu_re = jnp.einsum('blgc,gpc->blgp', uf, bb_re)
    bu_im = jnp.einsum('blgc,gpc->blgp', uf, bb_im)
    a_re = jnp.broadcast_to(ab_re, bu_re.shape)
    a_im = jnp.broadcast_to(ab_im, bu_im.shape)

    def combine(e1, e2):
        a1r, a1i, b1r, b1i = e1
        a2r, a2i, b2r, b2i = e2
        return (a2r * a1r - a2i * a1i, a2r * a1i + a2i * a1r,
                a2r * b1r - a2i * b1i + b2r, a2r * b1i + a2i * b1r + b2i)

    _, _, s_re, s_im = lax.associative_scan(combine, (a_re, a_im, bu_re, bu_im), axis=1)
    t1 = jnp.arange(1, l + 1, dtype=jnp.float32)[:, None, None]
    pm = jnp.exp(lr * step * t1)
    pa = li * step * t1
    p_re = pm * jnp.cos(pa)
    p_im = pm * jnp.sin(pa)
    s0r = s0_re[:, None]
    s0i = s0_im[:, None]
    s_re = s_re + p_re * s0r - p_im * s0i
    s_im = s_im + p_re * s0i + p_im * s0r
    y = (jnp.einsum('blgp,gcp->blgc', s_re, c_re.astype(jnp.float32))
         - jnp.einsum('blgp,gcp->blgc', s_im, c_im.astype(jnp.float32))
         + uf * d_skip.astype(jnp.float32).reshape(S5_GROUPS, S5_CH))
    y = jax.nn.gelu(y.reshape(bn, l, BRANCH))
    y = y * jax.nn.sigmoid(jnp.einsum('blc,cn->bln', y, w_glu.astype(jnp.float32)))
    return y, s_re[:, -1], s_im[:, -1]


def gated_chunk_scan(q, k, v, g, s0):
    bn, h, l, dk = q.shape
    dv = v.shape[-1]
    c = math.gcd(l, GATED_CHUNK)
    n = l // c
    causal = jnp.tril(jnp.ones((c, c), dtype=bool))[:, :, None]

    def to_chunks(t):
        return jnp.moveaxis(t.reshape(bn, h, n, c, t.shape[-1]), 2, 0)

    def step(S, inp):
        qc, kc, vc, gc = inp
        b = jnp.cumsum(gc, axis=2)
        diff = b[:, :, :, None, :] - b[:, :, None, :, :]
        w = jnp.where(causal, jnp.exp(jnp.where(causal, diff, 0.0)), 0.0)
        att = jnp.einsum('bhtk,bhsk,bhtsk->bhts', qc, kc, w)
        o = (jnp.einsum('bhtk,bhkv->bhtv', qc * jnp.exp(b), S)
             + jnp.einsum('bhts,bhsv->bhtv', att, vc))
        b_last = b[:, :, -1:, :]
        S = (S * jnp.exp(b_last)[:, :, 0, :, None]
             + jnp.einsum('bhsk,bhsv->bhkv', kc * jnp.exp(b_last - b), vc))
        return S, o

    S, o = lax.scan(step, s0, (to_chunks(q), to_chunks(k), to_chunks(v), to_chunks(g)))
    return jnp.moveaxis(o, 0, 2).reshape(bn, h, l, dv), S


def retention_chunk_scan(q, k, v, s0):
    bn, h, l, dk = q.shape
    dv = v.shape[-1]
    c = math.gcd(l, RET_CHUNK)
    n = l // c
    log_gamma = jnp.log1p(-jnp.exp2(-5.0 - jnp.arange(h, dtype=jnp.float32)))
    idx = jnp.arange(c, dtype=jnp.float32)
    rel = idx[:, None] - idx[None, :]
    causal = rel >= 0
    decay = jnp.where(causal, jnp.exp(jnp.where(causal, rel, 0.0)[None] * log_gamma[:, None, None]), 0.0)
    inner = jnp.exp((idx[None, :] + 1.0) * log_gamma[:, None])
    kdec = jnp.exp((c - 1.0 - idx[None, :]) * log_gamma[:, None])
    cdec = jnp.exp(c * log_gamma)

    def to_chunks(t):
        return jnp.moveaxis(t.reshape(bn, h, n, c, t.shape[-1]), 2, 0)

    def step(S, inp):
        qc, kc, vc = inp
        o_inter = jnp.einsum('bhtk,bhkv->bhtv', qc, S) * inner[None, :, :, None]
        scores = jnp.einsum('bhtk,bhsk->bhts', qc, kc) * decay[None]
        o = o_inter + jnp.einsum('bhts,bhsv->bhtv', scores, vc)
        S = (S * cdec[None, :, None, None]
             + jnp.einsum('bhsk,bhsv->bhkv', kc * kdec[None, :, :, None], vc))
        return S, o

    S, o = lax.scan(step, s0, (to_chunks(q), to_chunks(k), to_chunks(v)))
    return jnp.moveaxis(o, 0, 2).reshape(bn, h, l, dv), S


def mixer_layer(x, pos, s5_re0, s5_im0, hg0, gla0, ret0, lb, p):
    f32 = jnp.float32
    h = rmsnorm(x, p['norm_w'])
    proj = jnp.einsum('bld,dn->bln', h, p['w_in']).astype(f32)
    offs = [int(o) for o in np.cumsum(SPLIT_WIDTHS)[:-1]]
    (s5_u, s5_z, hg_q, hg_f, hg_i, hg_z, gla_q, gla_k, gla_v, gla_lr, gla_z,
     ret_q, ret_k, ret_v, ret_z) = jnp.split(proj, offs, axis=-1)

    y_s5, s5_re, s5_im = s5_branch(s5_u, s5_re0.astype(f32), s5_im0.astype(f32), p['s5_lam_re'], p['s5_lam_im'],
                                   p['s5_log_step'], p['s5_b_re'], p['s5_b_im'], p['s5_c_re'], p['s5_c_im'],
                                   p['s5_d'], p['s5_w_glu'])

    lbh = lb.reshape(HG_HEADS, 1, HG_DK)
    log_f = jnp.logaddexp(jnp.log(lbh), jnp.log1p(-lbh) + jax.nn.log_sigmoid(split_heads(hg_f, HG_HEADS)))
    o_hg, hg_new = gated_chunk_scan(split_heads(hg_q, HG_HEADS), -jnp.expm1(log_f),
                                    split_heads(hg_i, HG_HEADS), log_f, hg0.astype(f32))
    y_hg = merge_heads(head_rmsnorm(o_hg, p['hgrn_norm_w']))

    g_gla = jax.nn.log_sigmoid(jnp.einsum('blr,rn->bln', gla_lr, p['gla_w_gate_up'].astype(f32))
                               + p['gla_b_gate'].astype(f32)) / GLA_TAU
    o_gla, gla_new = gated_chunk_scan(split_heads(gla_q, GLA_HEADS) * GLA_DK ** -0.5,
                                      split_heads(gla_k, GLA_HEADS), split_heads(gla_v, GLA_HEADS),
                                      split_heads(g_gla, GLA_HEADS), gla0.astype(f32))
    y_gla = merge_heads(head_rmsnorm(o_gla, p['gla_norm_w']))

    rq = rotary(split_heads(ret_q, RET_HEADS), pos)
    rk = rotary(split_heads(ret_k, RET_HEADS), pos) * RET_DK ** -0.5
    o_ret, ret_new = retention_chunk_scan(rq, rk, split_heads(ret_v, RET_HEADS), ret0.astype(f32))
    y_ret = merge_heads(head_layernorm(o_ret, p['ret_norm_w']))

    mix = jnp.concatenate([y_s5 * jax.nn.silu(s5_z), y_hg * jax.nn.silu(hg_z),
                           y_gla * jax.nn.silu(gla_z), y_ret * jax.nn.silu(ret_z)], axis=-1)
    out = jnp.einsum('bln,nd->bld', mix, p['w_out'].astype(f32))
    return x + out.astype(x.dtype), (s5_re, s5_im, hg_new, gla_new, ret_new)


def setup_inputs(seed: int = 0) -> dict:
    key = jax.random.key(seed)
    ks = jax.random.split(key, 26)
    f32 = jnp.float32
    nrm = lambda k, s, sc: jax.random.normal(k, s, f32) * sc
    lam_re = -0.5 * jnp.exp(nrm(ks[14], (DEPTH, S5_GROUPS, S5_STATE), 0.05))
    lam_im = math.pi * jnp.arange(S5_STATE, dtype=f32)[None, None, :] + nrm(ks[15], (DEPTH, S5_GROUPS, S5_STATE), 0.05)
    log_step = math.log(1e-3) + jax.random.uniform(ks[16], (DEPTH, S5_GROUPS), f32) * (math.log(1e-1) - math.log(1e-3))
    return {
        'x_prompt': nrm(ks[0], (BATCH, SEQ, D_MODEL), 1.0),
        'x_sample': nrm(ks[1], (DEC_BATCH, DEC_SEQ, D_MODEL), 1.0),
        'state_s5_re': nrm(ks[2], (DEPTH, DEC_BATCH, S5_GROUPS, S5_STATE), 0.5),
        'state_s5_im': nrm(ks[3], (DEPTH, DEC_BATCH, S5_GROUPS, S5_STATE), 0.5),
        'state_hgrn': nrm(ks[4], (DEPTH, DEC_BATCH, HG_HEADS, HG_DK, HG_DV), 0.3),
        'state_gla': nrm(ks[5], (DEPTH, DEC_BATCH, GLA_HEADS, GLA_DK, GLA_DV), 0.3),
        'state_ret': nrm(ks[6], (DEPTH, DEC_BATCH, RET_HEADS, RET_DK, RET_DV), 0.3),
        'norm_w': 1.0 + nrm(ks[7], (DEPTH, D_MODEL), 0.02),
        'final_norm_w': 1.0 + nrm(ks[8], (D_MODEL,), 0.02),
        'w_in': nrm(ks[9], (DEPTH, D_MODEL, N_IN), D_MODEL ** -0.5),
        'w_out': nrm(ks[10], (DEPTH, MIX_WIDTH, D_MODEL), MIX_WIDTH ** -0.5),
        's5_lam_re': lam_re,
        's5_lam_im': lam_im,
        's5_log_step': log_step,
        's5_b_re': nrm(ks[11], (DEPTH, S5_GROUPS, S5_STATE, S5_CH), (2 * S5_CH) ** -0.5),
        's5_b_im': nrm(ks[12], (DEPTH, S5_GROUPS, S5_STATE, S5_CH), (2 * S5_CH) ** -0.5),
        's5_c_re': nrm(ks[13], (DEPTH, S5_GROUPS, S5_CH, S5_STATE), (2 * S5_STATE) ** -0.5),
        's5_c_im': nrm(ks[17], (DEPTH, S5_GROUPS, S5_CH, S5_STATE), (2 * S5_STATE) ** -0.5),
        's5_d': nrm(ks[18], (DEPTH, BRANCH), 1.0),
        's5_w_glu': nrm(ks[19], (DEPTH, BRANCH, BRANCH), BRANCH ** -0.5),
        'hgrn_lb_logits': nrm(ks[20], (DEPTH, HG_HEADS * HG_DK), 1.0),
        'hgrn_norm_w': 1.0 + nrm(ks[21], (DEPTH, BRANCH), 0.02),
        'gla_w_gate_up': nrm(ks[22], (DEPTH, GLA_LOWRANK, GLA_HEADS * GLA_DK), GLA_LOWRANK ** -0.5),
        'gla_b_gate': nrm(ks[23], (DEPTH, GLA_HEADS * GLA_DK), 0.1),
        'gla_norm_w': 1.0 + nrm(ks[24], (DEPTH, BRANCH), 0.02),
        'ret_norm_w': 1.0 + nrm(ks[25], (DEPTH, BRANCH), 0.02),
    }


def reference(x_prompt, x_sample, state_s5_re, state_s5_im, state_hgrn, state_gla, state_ret,
              norm_w, final_norm_w, w_in, w_out, s5_lam_re, s5_lam_im, s5_log_step,
              s5_b_re, s5_b_im, s5_c_re, s5_c_im, s5_d, s5_w_glu, hgrn_lb_logits, hgrn_norm_w,
              gla_w_gate_up, gla_b_gate, gla_norm_w, ret_norm_w):
    f32 = jnp.float32
    bp, lp = x_prompt.shape[0], x_prompt.shape[1]
    ls = x_sample.shape[1]
    pos_p = jnp.arange(lp)
    pos_s = PAST_LEN + jnp.arange(ls)
    lb_all = jnp.cumsum(jax.nn.softmax(hgrn_lb_logits.astype(f32), axis=0), axis=0)
    lb_all = lb_all - lb_all[0:1]

    xp, xs = x_prompt, x_sample
    new_p = ([], [], [], [], [])
    new_s = ([], [], [], [], [])
    for l in range(DEPTH):
        p = {
            'norm_w': norm_w[l], 'w_in': w_in[l], 'w_out': w_out[l],
            's5_lam_re': s5_lam_re[l], 's5_lam_im': s5_lam_im[l], 's5_log_step': s5_log_step[l],
            's5_b_re': s5_b_re[l], 's5_b_im': s5_b_im[l], 's5_c_re': s5_c_re[l], 's5_c_im': s5_c_im[l],
            's5_d': s5_d[l], 's5_w_glu': s5_w_glu[l], 'hgrn_norm_w': hgrn_norm_w[l],
            'gla_w_gate_up': gla_w_gate_up[l], 'gla_b_gate': gla_b_gate[l], 'gla_norm_w': gla_norm_w[l],
            'ret_norm_w': ret_norm_w[l],
        }
        xp, st_p = mixer_layer(xp, pos_p,
                               jnp.zeros((bp, S5_GROUPS, S5_STATE), f32), jnp.zeros((bp, S5_GROUPS, S5_STATE), f32),
                               jnp.zeros((bp, HG_HEADS, HG_DK, HG_DV), f32),
                               jnp.zeros((bp, GLA_HEADS, GLA_DK, GLA_DV), f32),
                               jnp.zeros((bp, RET_HEADS, RET_DK, RET_DV), f32),
                               lb_all[l], p)
        xs, st_s = mixer_layer(xs, pos_s, state_s5_re[l], state_s5_im[l], state_hgrn[l], state_gla[l],
                               state_ret[l], lb_all[l], p)
        for i in range(5):
            new_p[i].append(st_p[i])
            new_s[i].append(st_s[i])
    y_prompt = rmsnorm(xp, final_norm_w)
    y_sample = rmsnorm(xs, final_norm_w)
    return (y_prompt, y_sample,
            jnp.stack(new_p[0]), jnp.stack(new_p[1]), jnp.stack(new_p[2]), jnp.stack(new_p[3]), jnp.stack(new_p[4]),
            jnp.stack(new_s[0]), jnp.stack(new_s[1]), jnp.stack(new_s[2]), jnp.stack(new_s[3]), jnp.stack(new_s[4]))
```

```cpp
#include <hip/hip_runtime.h>
#include <cstdio>
#include <cstdint>
namespace pg8 {
#define PG8_LAS __attribute__((address_space(3)))
typedef unsigned short bf16_t;
typedef short bf16x8 __attribute__((ext_vector_type(8)));
typedef float f32x4 __attribute__((ext_vector_type(4)));
typedef unsigned u32x4 __attribute__((ext_vector_type(4)));
constexpr int BM = 256, BK = 64, HALF = 128, HTB = HALF * BK * 2  , STAGE_BYTES = 8 * HTB, NXCD = 8, WGM = 8;

__host__ __device__ __forceinline__ int lds_byte(int r, int c) { const int st = (r >> 4) * 2 + (c >> 5), rr = r & 15, cc = c & 31, ob = rr * 64 + cc * 2; return st * 1024 + (ob ^ (((ob >> 9) & 1) << 5)); }
__host__ __device__ __forceinline__ void stage_rc(int b, int& R, int& C) { const int st = b / 1024, sb = b % 1024, swz = sb ^ (((sb >> 9) & 1) << 5); R = (st >> 1) * 16 + swz / 64; C = (st & 1) * 32 + (swz % 64) / 2; }
__host__ __device__ __forceinline__ int perm32(int rho) { const int n = rho >> 4, i = rho & 15; return 8 * (i >> 2) + 4 * n + (i & 3); }

struct Unit { int pm, pn; };
struct Gemm { const bf16_t* A; const bf16_t* Bt; int M, N, K; };

struct StaticOrder {
    int nM, nN, nwg, G, c;
    __host__ __device__ __forceinline__ void init(int M, int N, int G_, int c_) { nM = M / BM; nN = N / BM; nwg = nM * nN; G = G_; c = c_; }
    __host__ __device__ __forceinline__ bool next(int i, Unit& u) const {
        const long L = (long)i * G + c; if (L >= nwg) return false;
        int wgid = (int)L; { const int q = nwg / NXCD, r = nwg % NXCD, xcd = wgid % NXCD, off = wgid / NXCD; wgid = (xcd < r ? xcd * (q + 1) : r * (q + 1) + (xcd - r) * q) + off; }
        const int nig = WGM * nN, gid = wgid / nig, fm = gid * WGM, gsz = (nM - fm) < WGM ? (nM - fm) : WGM;
        u.pm = fm + ((wgid % nig) % gsz); u.pn = (wgid % nig) / gsz; return true;
    }
    __device__ __forceinline__ void a_ready(const Unit&) const {}
    __device__ __forceinline__ void done(const Unit&) const {}
};
__device__ __forceinline__ unsigned cvt_pk_bf16(float lo, float hi) { unsigned r; asm volatile("v_cvt_pk_bf16_f32 %0, %1, %2" : "=v"(r) : "v"(lo), "v"(hi)); return r; }
template <class Epi, class Sched, bool ALIGN_EPI = false, bool SP2 = false>
__device__ __forceinline__ void gemm_phase(PG8_LAS unsigned char* lds, const Gemm g, const Sched& S, const Epi& E) {
    int tid_ = threadIdx.x; asm volatile("" : "+v"(tid_)); const int tid = tid_, wid = __builtin_amdgcn_readfirstlane(tid >> 6), lane = tid & 63, wr = wid >> 2, wc = wid & 3, fr = lane & 15, fq = lane >> 4;
    const int K = g.K, nt = K / BK;
    unsigned voffA[2], voffB[2];
#pragma unroll
    for (int i = 0; i < 2; ++i) { int R, C; stage_rc(tid * 16 + i * 8192, R, C); const int Rb = Epi::PERM ? ((R & ~31) + perm32(R & 31)) : R;
        voffA[i] = (unsigned)(R * K + C) * 2u; voffB[i] = (unsigned)(Rb * K + C) * 2u; }
    const size_t kstep = (size_t)(BK * 2);
    const size_t hstep = (size_t)HALF * K * 2;
    const size_t tstep = 2 * hstep;
    const unsigned ldsw = (unsigned)wid * 1024u;
    const int aoff = lds_byte(wr * 64 + fr, fq * 8), boff = lds_byte(wc * 32 + fr, fq * 8);
#define PG8_SA(b, h) (((b) * 2 + (h)) * HTB)
#define PG8_SB(b, h) ((4 + (b) * 2 + (h)) * HTB)
#define PG8_STAGE(bufoff, gbase, voff) do { _Pragma("unroll") for (int _i = 0; _i < 2; ++_i) \
        __builtin_amdgcn_global_load_lds((const unsigned*)((const char*)(gbase) + (voff)[_i]), (PG8_LAS unsigned*)(lds + (bufoff) + ldsw + _i * 8192), 16, 0, 0); } while (0)
#define PG8_LDA(dst, b, h) do { _Pragma("unroll") for (int m = 0; m < 4; ++m) _Pragma("unroll") for (int k = 0; k < 2; ++k) dst[m][k] = *(const PG8_LAS bf16x8*)(lds + PG8_SA(b, h) + aoff + m * 2048 + k * 1024); } while (0)
#define PG8_LDB(dst, b, h) do { _Pragma("unroll") for (int n = 0; n < 2; ++n) _Pragma("unroll") for (int k = 0; k < 2; ++k) dst[n][k] = *(const PG8_LAS bf16x8*)(lds + PG8_SB(b, h) + boff + n * 2048 + k * 1024); } while (0)
#define PG8_MMA(ai, bj, At, Bt) do { __builtin_amdgcn_s_setprio(1); _Pragma("unroll") for (int m = 0; m < 4; ++m) _Pragma("unroll") for (int n = 0; n < 2; ++n) _Pragma("unroll") for (int k = 0; k < 2; ++k) \
        acc[ai][bj][m][n] = __builtin_amdgcn_mfma_f32_16x16x32_bf16(Bt[n][k], At[m][k], acc[ai][bj][m][n], 0, 0, 0); __builtin_amdgcn_s_setprio(0); } while (0)
#define PG8_WAIT_V(n) asm volatile("s_waitcnt vmcnt(" #n ")" ::: "memory")
#define PG8_WAIT_L(n) asm volatile("s_waitcnt lgkmcnt(" #n ")" ::: "memory")
#define PG8_BAR __builtin_amdgcn_s_barrier()
#define PG8_SCHED __builtin_amdgcn_sched_barrier(0)
    Unit cur, nxt; int ui = 0;
    if (!S.next(0, cur)) return;
    f32x4 acc[2][2][4][2];
#pragma unroll
    for (int a = 0; a < 2; ++a)
#pragma unroll
        for (int b = 0; b < 2; ++b)
#pragma unroll
            for (int m = 0; m < 4; ++m)
#pragma unroll
                for (int n = 0; n < 2; ++n) acc[a][b][m][n] = (f32x4){0.f, 0.f, 0.f, 0.f};
    bf16x8 At[4][2], B0[2][2], B1[2][2];
    const char* cA = (const char*)g.A + (size_t)cur.pm * tstep; const char* cB = (const char*)g.Bt + (size_t)cur.pn * tstep;
    S.a_ready(cur);
    if constexpr (SP2) {
        PG8_STAGE(PG8_SB(0, 0), cB, voffB); PG8_STAGE(PG8_SB(0, 1), cB + hstep, voffB); PG8_STAGE(PG8_SA(0, 0), cA, voffA); PG8_STAGE(PG8_SA(0, 1), cA + hstep, voffA);
        if (wr == 1) PG8_BAR;
        PG8_WAIT_V(2); PG8_BAR;
        PG8_STAGE(PG8_SB(1, 0), cB + kstep, voffB); PG8_STAGE(PG8_SA(1, 0), cA + kstep, voffA); PG8_STAGE(PG8_SB(1, 1), cB + hstep + kstep, voffB);
        PG8_WAIT_V(6); PG8_BAR;
    } else {
        PG8_STAGE(PG8_SB(0, 0), cB, voffB); PG8_STAGE(PG8_SA(0, 0), cA, voffA); PG8_STAGE(PG8_SB(0, 1), cB + hstep, voffB); PG8_STAGE(PG8_SA(0, 1), cA + hstep, voffA);
        if (wr == 1) PG8_BAR;
        PG8_WAIT_V(4); PG8_BAR;
        PG8_STAGE(PG8_SB(1, 0), cB + kstep, voffB); PG8_STAGE(PG8_SA(1, 0), cA + kstep, voffA); PG8_STAGE(PG8_SB(1, 1), cB + hstep + kstep, voffB);
        PG8_WAIT_V(6); PG8_BAR;
    }
    for (;;) {
        const bool has_next = S.next(ui + 1, nxt);
        const char* nA = has_next ? (const char*)g.A + (size_t)nxt.pm * tstep : cA; const char* nB = has_next ? (const char*)g.Bt + (size_t)nxt.pn * tstep : cB;
        for (int t = 0; t < nt; t += 2) {
            const bool last = (t == nt - 2);
            const char* a1 = cA + (size_t)(t + 1) * kstep;
            const char* a2 = last ? nA : cA + (size_t)(t + 2) * kstep; const char* b2 = last ? nB : cB + (size_t)(t + 2) * kstep;
            const char* a3 = a2 + kstep; const char* b3 = b2 + kstep;
            if (last && has_next) S.a_ready(nxt);
            if constexpr (SP2) {
            PG8_LDB(B0, 0, 0); PG8_LDB(B1, 0, 1); PG8_SCHED; PG8_LDA(At, 0, 0); PG8_STAGE(PG8_SA(1, 1), a1 + hstep, voffA);
            PG8_WAIT_V(8); PG8_WAIT_L(0); PG8_BAR; PG8_MMA(0, 0, At, B0); PG8_MMA(0, 1, At, B1); PG8_BAR; PG8_SCHED;
            PG8_LDA(At, 0, 1); PG8_STAGE(PG8_SB(0, 0), b2, voffB); PG8_STAGE(PG8_SB(0, 1), b2 + hstep, voffB); PG8_STAGE(PG8_SA(0, 0), a2, voffA);
            PG8_WAIT_V(8); PG8_WAIT_L(0); PG8_BAR; PG8_MMA(1, 0, At, B0); PG8_MMA(1, 1, At, B1); PG8_BAR; PG8_SCHED;
            PG8_LDB(B0, 1, 0); PG8_LDB(B1, 1, 1); PG8_SCHED; PG8_LDA(At, 1, 0); PG8_STAGE(PG8_SA(0, 1), a2 + hstep, voffA);
            PG8_WAIT_V(8); PG8_WAIT_L(0); PG8_BAR; PG8_MMA(0, 0, At, B0); PG8_MMA(0, 1, At, B1); PG8_BAR; PG8_SCHED;
            PG8_LDA(At, 1, 1); PG8_STAGE(PG8_SB(1, 0), b3, voffB); PG8_STAGE(PG8_SB(1, 1), b3 + hstep, voffB); PG8_STAGE(PG8_SA(1, 0), a3, voffA);
            PG8_WAIT_V(8); PG8_WAIT_L(0); PG8_BAR; PG8_MMA(1, 0, At, B0); PG8_MMA(1, 1, At, B1); PG8_BAR; PG8_SCHED;
            } else {
            PG8_LDB(B0, 0, 0); PG8_SCHED; PG8_LDA(At, 0, 0); PG8_STAGE(PG8_SA(1, 1), a1 + hstep, voffA);
            PG8_WAIT_L(8); PG8_BAR; PG8_WAIT_L(0); PG8_MMA(0, 0, At, B0); PG8_BAR; PG8_SCHED;
            PG8_LDB(B1, 0, 1); PG8_STAGE(PG8_SB(0, 0), b2, voffB);
            PG8_BAR; PG8_WAIT_L(0); PG8_MMA(0, 1, At, B1); PG8_BAR;
            PG8_LDA(At, 0, 1); PG8_STAGE(PG8_SA(0, 0), a2, voffA);
            PG8_BAR; PG8_WAIT_L(0); PG8_MMA(1, 0, At, B0); PG8_BAR; PG8_SCHED;
            PG8_STAGE(PG8_SB(0, 1), b2 + hstep, voffB);
            PG8_WAIT_V(6); PG8_BAR; PG8_MMA(1, 1, At, B1); PG8_BAR;
            PG8_LDB(B0, 1, 0); PG8_SCHED; PG8_LDA(At, 1, 0); PG8_STAGE(PG8_SA(0, 1), a2 + hstep, voffA);
            PG8_WAIT_L(8); PG8_BAR; PG8_WAIT_L(0); PG8_MMA(0, 0, At, B0); PG8_BAR; PG8_SCHED;
            PG8_LDB(B1, 1, 1); PG8_STAGE(PG8_SB(1, 0), b3, voffB);
            PG8_BAR; PG8_WAIT_L(0); PG8_MMA(0, 1, At, B1); PG8_BAR;
            PG8_LDA(At, 1, 1); PG8_STAGE(PG8_SA(1, 0), a3, voffA);
            PG8_BAR; PG8_WAIT_L(0); PG8_MMA(1, 0, At, B0); PG8_BAR; PG8_SCHED;
            PG8_STAGE(PG8_SB(1, 1), b3 + hstep, voffB);
            PG8_WAIT_V(6); PG8_BAR; PG8_MMA(1, 1, At, B1); PG8_BAR;
            }
        }
        if constexpr (ALIGN_EPI) { if (wr == 0) PG8_BAR; }
        if constexpr (!Epi::AFTER_DRAIN) { E(acc, cur, wr, wc, fr, fq); S.done(cur); }
        if (!has_next) break;
#pragma unroll
        for (int a = 0; a < 2; ++a)
#pragma unroll
            for (int b = 0; b < 2; ++b)
#pragma unroll
                for (int m = 0; m < 4; ++m)
#pragma unroll
                    for (int n = 0; n < 2; ++n) acc[a][b][m][n] = (f32x4){0.f, 0.f, 0.f, 0.f};
        cur = nxt; cA = nA; cB = nB; ++ui;
        if constexpr (ALIGN_EPI) { if (wr == 1) PG8_BAR; }
    }
    PG8_WAIT_V(0);
    if constexpr (!ALIGN_EPI) { if (wr == 0) PG8_BAR; }
    PG8_BAR;
    if constexpr (Epi::AFTER_DRAIN) { E.fused(acc, cur, wr, wc, fr, fq, lds, wid, lane); S.done(cur); }
#undef PG8_SA
#undef PG8_SB
#undef PG8_STAGE
#undef PG8_LDA
#undef PG8_LDB
#undef PG8_MMA
#undef PG8_WAIT_V
#undef PG8_WAIT_L
#undef PG8_BAR
#undef PG8_SCHED
}
}

#ifndef MK_N_LAUNCHES
#define MK_N_LAUNCHES 1
#endif
constexpr int N_PHASES = 12;
#ifndef DUP_MASK
#define DUP_MASK 0
#endif
#define NREP(k) ((((DUP_MASK) >> (k)) & 1) ? 2 : 1)
constexpr int N_LAUNCHES = MK_N_LAUNCHES;
constexpr int NWAVES = 8;
constexpr int DM = 1024, NBATCH = 8, SEQ = 2048, TP = NBATCH * SEQ, NS = 128, TT = TP + NS;
constexpr int NPROJ = 3072;
constexpr int NIN = 3088;
constexpr int CH = 64, NCH = SEQ / CH, NBC = NBATCH * NCH;
constexpr float EPS = 1e-6f;
constexpr int POS_S = 16384;
constexpr int C_S5U = 0, C_S5Z = 256, C_HGQ = 512, C_HGF = 768, C_HGI = 1024, C_HGZ = 1280, C_GLQ = 1536, C_GLK = 1664, C_GLV = 1792, C_GLZ = 2048, C_RTQ = 2304, C_RTK = 2432, C_RTV = 2560, C_RTZ = 2816;
enum { I_XP = 0, I_XS, I_S5RE, I_S5IM, I_SHG, I_SGLA, I_SRET, I_NORMW, I_FNORMW, I_WIN, I_WOUT, I_LAMRE, I_LAMIM, I_LOGSTEP, I_BRE, I_BIM, I_CRE, I_CIM, I_S5D, I_WGLU, I_LBLOG, I_HGNW, I_GLWUP, I_GLB, I_GLNW, I_RTNW, N_INPUTS };
constexpr size_t O_YP = 0, O_YS = O_YP + (size_t)TP * DM, O_S5RE_P = O_YS + (size_t)NS * DM, O_S5IM_P = O_S5RE_P + 2 * 8 * 1024, O_HG_P = O_S5IM_P + 2 * 8 * 1024,
    O_GLA_P = O_HG_P + 2 * 8 * 16384, O_RET_P = O_GLA_P + 2 * 8 * 8192, O_S5RE_S = O_RET_P + 2 * 8 * 8192, O_S5IM_S = O_S5RE_S + 2 * 128 * 1024, O_HG_S = O_S5IM_S + 2 * 128 * 1024,
    O_GLA_S = O_HG_S + (size_t)2 * 128 * 16384, O_RET_S = O_GLA_S + (size_t)2 * 128 * 8192, O_END = O_RET_S + (size_t)2 * 128 * 8192;

constexpr size_t MiB = 1u << 20;
constexpr size_t WS_CTL = 0, CTL_ZERO_BYTES = 64 * 1024;
constexpr size_t WS_WIN = 2 * MiB;
constexpr size_t WS_WOUT = 14 * MiB;
constexpr size_t WS_WLR = 18 * MiB;
constexpr size_t WS_WGLU = WS_WLR + 64 * 1024;
constexpr size_t WS_BBT = WS_WGLU + 256 * 1024;
constexpr size_t WS_CCN = WS_BBT + 128 * 1024;
constexpr size_t WS_S5A = WS_CCN + 128 * 1024;
constexpr size_t WS_LB = WS_S5A + 32 * 1024;
constexpr size_t WS_ROT = WS_LB + 4 * 1024;
constexpr size_t WS_XB = 20 * MiB;
constexpr size_t WS_ROWSS = 53 * MiB;
constexpr size_t WS_ROWSS_S = WS_ROWSS + (size_t)TP * 16 * 4;
constexpr size_t WS_LR = 55 * MiB;
constexpr size_t WS_PROJ = 57 * MiB;
constexpr size_t WS_MIX = 154 * MiB;
constexpr size_t WS_SLOC = 187 * MiB;
constexpr size_t WS_DEC = 219 * MiB;
constexpr size_t WS_S5LOC = 220 * MiB;
constexpr size_t WS_END = 224 * MiB;
static_assert(WS_ROT + 2 * 2048 * 16 * 4 + 256 <= WS_XB && WS_XB + (size_t)TT * DM * 2 <= WS_ROWSS && WS_ROWSS_S + 128 * 32 * 4 <= WS_LR && WS_LR + (size_t)TT * 16 * 4 <= WS_PROJ, "ws map");
static_assert(WS_PROJ + (size_t)TT * NPROJ * 2 <= WS_MIX && WS_MIX + (size_t)TT * DM * 2 <= WS_SLOC && WS_SLOC + (size_t)NBC * 32768 * 4 <= WS_DEC && WS_DEC + (size_t)NBC * 512 * 4 <= WS_S5LOC && WS_S5LOC + (size_t)NBC * 2048 * 4 <= WS_END, "ws map");
constexpr int CW_BAR = 4096;

constexpr int RING_BYTES = 131072;
constexpr int LDSCTL_OFF = RING_BYTES, MISC_OFF = LDSCTL_OFF + 320;
constexpr int LDS_BYTES = 147456;

#define LAS __attribute__((address_space(3)))
typedef unsigned short bf16;
typedef short bf16x8 __attribute__((ext_vector_type(8)));
typedef short bf16x4 __attribute__((ext_vector_type(4)));
typedef float f32x4 __attribute__((ext_vector_type(4)));
typedef float f32x2 __attribute__((ext_vector_type(2)));
typedef float f32x16 __attribute__((ext_vector_type(16)));
typedef unsigned u32x4 __attribute__((ext_vector_type(4)));
typedef unsigned u32x2 __attribute__((ext_vector_type(2)));
#define RLX_AGENT __ATOMIC_RELAXED, __HIP_MEMORY_SCOPE_AGENT
#define LDS_WAIT() asm volatile("s_waitcnt lgkmcnt(0)" ::: "memory")
#define VM_WAIT() asm volatile("s_waitcnt vmcnt(0)" ::: "memory")

__device__ __forceinline__ void bsync() { __builtin_amdgcn_fence(__ATOMIC_RELEASE, "workgroup"); __builtin_amdgcn_s_barrier(); __builtin_amdgcn_fence(__ATOMIC_ACQUIRE, "workgroup"); }
__device__ __forceinline__ unsigned f2bf(float f) { unsigned u = __builtin_bit_cast(unsigned, f); return (u + 0x7fffu + ((u >> 16) & 1u)) >> 16; }
__device__ __forceinline__ unsigned pk2(float lo, float hi) { return f2bf(lo) | (f2bf(hi) << 16); }
__device__ __forceinline__ float bf2f(short b) { return __builtin_bit_cast(float, ((unsigned)(unsigned short)b) << 16); }
__device__ __forceinline__ u32x4 pack8(const float* v) { u32x4 w; w.x = pk2(v[0], v[1]); w.y = pk2(v[2], v[3]); w.z = pk2(v[4], v[5]); w.w = pk2(v[6], v[7]); return w; }
__device__ __forceinline__ float sigmoidf_(float x) { return 1.0f / (1.0f + __expf(-x)); }
__device__ __forceinline__ float siluf_(float x) { return x / (1.0f + __expf(-x)); }
__device__ __forceinline__ float logsigmoidf_(float x) { return fminf(x, 0.f) - log1pf(__expf(-fabsf(x))); }
__device__ __forceinline__ float gelu_tanh(float x) { const float u = 0.7978845608028654f * (x + 0.044715f * x * x * x); return 0.5f * x * (1.0f + tanhf(u)); }
__device__ __forceinline__ float wave_sum(float v) {
#pragma unroll
    for (int o = 1; o < 64; o <<= 1) v += __shfl_xor(v, o);
    return v;
}

#define XB_TMO      128
#define XB_XCNT(j)  (256  + 64 * (j))
#define XB_XSUB(j)  (1280 + 64 * (j))
#define XB_XGEN(j)  (2304 + 64 * (j))
#define XB_TOP      3328
#define XB_TOPGEN   3392
#define XCD_BAR_WORDS 3456
#define XB_SPIN_CAP (1u << 18)
__device__ __forceinline__ unsigned xb_ld(unsigned* p)              { return __hip_atomic_load(p, __ATOMIC_RELAXED, __HIP_MEMORY_SCOPE_AGENT); }
__device__ __forceinline__ unsigned xb_add(unsigned* p, unsigned v) { return __hip_atomic_fetch_add(p, v, __ATOMIC_RELAXED, __HIP_MEMORY_SCOPE_AGENT); }
__device__ __forceinline__ unsigned xb_xcc_id() { return (unsigned)__builtin_amdgcn_s_getreg((3 << 11) | 20) & 0xFu; }
#define XB_SPIN(cond, bar) do { unsigned _sp = 0; while (cond) { __builtin_amdgcn_s_sleep(1); \
    if ((++_sp & 255u) == 0u) { if (xb_ld(&(bar)[XB_TMO])) break; if (_sp > XB_SPIN_CAP) { atomicAdd(&(bar)[XB_TMO], 1u); break; } } } } while (0)
struct XcdBarrier { unsigned* bar; unsigned x; volatile LAS unsigned* st; };
__device__ __forceinline__ XcdBarrier xcd_barrier_post(unsigned* bar, volatile LAS unsigned* st) {
    XcdBarrier b; b.bar = bar; b.x = xb_xcc_id(); b.st = st;
    if (threadIdx.x == 0) (void)xb_add(&bar[XB_XCNT(b.x)], 1u);
    return b;
}
__device__ __forceinline__ void xcd_barrier_complete(unsigned* bar, unsigned x, unsigned& nloc, unsigned& nx) {
    const unsigned G = gridDim.x * gridDim.y * gridDim.z;
    unsigned sum, cnt, mine, sp = 0u;
    for (;;) {
        sum = 0u; cnt = 0u; mine = 0u;
#pragma unroll
        for (unsigned j = 0; j < 16; ++j) { const unsigned c = xb_ld(&bar[XB_XCNT(j)]); sum += c; cnt += (c > 0u) ? 1u : 0u; mine = (j == x) ? c : mine; }
        if (sum == G) break;
        __builtin_amdgcn_s_sleep(1);
        if ((++sp & 255u) == 0u) { if (xb_ld(&bar[XB_TMO])) break; if (sp > XB_SPIN_CAP) { atomicAdd(&bar[XB_TMO], 1u); break; } }
    }
    nloc = mine > 0u ? mine : 1u; nx = cnt > 0u ? cnt : 1u;
}
__device__ __forceinline__ void xcd_barrier(const XcdBarrier& b) {
    asm volatile("s_waitcnt vmcnt(0)" ::: "memory");
    bsync();
    if (threadIdx.x == 0) {
        unsigned* bar = b.bar;
        __builtin_amdgcn_s_waitcnt(0);
        unsigned nloc = b.st[0], nx = b.st[1];
        if (nloc == 0u) { xcd_barrier_complete(bar, b.x, nloc, nx); b.st[0] = nloc; b.st[1] = nx; }
        const unsigned old = xb_add(&bar[XB_XSUB(b.x)], 1u);
        const unsigned gen = old / nloc;
        if (old + 1u == (gen + 1u) * nloc) {
            __builtin_amdgcn_fence(__ATOMIC_RELEASE, "agent");
            asm volatile("s_waitcnt vmcnt(0)" ::: "memory");
            const unsigned og = xb_add(&bar[XB_TOP], 1u);
            const unsigned tg = og / nx;
            if (og + 1u == (tg + 1u) * nx) xb_add(&bar[XB_TOPGEN], 1u);
            else XB_SPIN(xb_ld(&bar[XB_TOPGEN]) == tg, bar);
            __builtin_amdgcn_fence(__ATOMIC_ACQUIRE, "agent");
            xb_add(&bar[XB_XGEN(b.x)], 1u);
            asm volatile("s_waitcnt vmcnt(0)" ::: "memory");
        } else {
            XB_SPIN(xb_ld(&bar[XB_XGEN(b.x)]) == gen, bar);
            __builtin_amdgcn_fence(__ATOMIC_ACQUIRE, "agent");
            asm volatile("s_waitcnt vmcnt(0)" ::: "memory");
        }
    }
    bsync();
}

struct Args { const float* in[N_INPUTS]; float* out; unsigned char* ws; int ph_lo, ph_hi, li, pad; };
#define KARG (F.kp)
#define INP(i) ((const float*)KARG->in[i])
#define OUTP ((float*)KARG->out)
#define WSP ((unsigned char*)KARG->ws)
#define P_WIN ((bf16*)(WSP + WS_WIN))
#define P_WOUT ((bf16*)(WSP + WS_WOUT))
#define P_WLR ((bf16*)(WSP + WS_WLR))
#define P_WGLU ((bf16*)(WSP + WS_WGLU))
#define P_BBT ((bf16*)(WSP + WS_BBT))
#define P_CCN ((bf16*)(WSP + WS_CCN))
#define P_XB ((bf16*)(WSP + WS_XB))
#define P_PROJ ((bf16*)(WSP + WS_PROJ))
#define P_MIX ((bf16*)(WSP + WS_MIX))
#define P_S5A ((float*)(WSP + WS_S5A))
#define P_LB ((float*)(WSP + WS_LB))
#define P_ROT ((float*)(WSP + WS_ROT))
#define P_ROWSS ((float*)(WSP + WS_ROWSS))
#define P_ROWSS_S ((float*)(WSP + WS_ROWSS_S))
#define P_LR ((float*)(WSP + WS_LR))
#define P_SLOC ((float*)(WSP + WS_SLOC))
#define P_DEC ((float*)(WSP + WS_DEC))
#define P_S5LOC ((float*)(WSP + WS_S5LOC))
typedef const __attribute__((address_space(4))) Args* KargPtr;
struct Frame { LAS unsigned char* lds; int tid, lane, wave, G, bid; KargPtr kp; };
__device__ __forceinline__ Frame fresh(const Frame& F0) {
    Frame R; R.lds = F0.lds; int t = F0.tid; asm volatile("" : "+v"(t)); R.tid = t; R.lane = t & 63; R.wave = __builtin_amdgcn_readfirstlane(t >> 6);
    int g = F0.G, b = F0.bid; asm volatile("" : "+s"(g), "+s"(b)); R.G = g; R.bid = b;
    KargPtr p = F0.kp; asm volatile("" : "+s"(p)); R.kp = p; return R;
}

namespace pg8 {
struct EpiProj {
    static constexpr bool PERM = true, AFTER_DRAIN = false;
    bf16_t* O; const float* rowss;
    __device__ __forceinline__ void operator()(const f32x4 (&acc)[2][2][4][2], const Unit& u, int wr, int wc, int fr, int fq) const {
        const int row0 = u.pm * BM + wr * 64 + fr, col0 = u.pn * BM + wc * 32 + 8 * fq;
#pragma unroll
        for (int ai = 0; ai < 2; ++ai)
#pragma unroll
            for (int m = 0; m < 4; ++m) {
                const int row = row0 + ai * HALF + m * 16;
                const f32x4* rp = (const f32x4*)(rowss + (size_t)row * 16);
                const f32x4 p0 = rp[0], p1 = rp[1], p2 = rp[2], p3 = rp[3];
                const float ss = ((p0[0] + p0[1]) + (p0[2] + p0[3])) + ((p1[0] + p1[1]) + (p1[2] + p1[3])) + ((p2[0] + p2[1]) + (p2[2] + p2[3])) + ((p3[0] + p3[1]) + (p3[2] + p3[3]));
                const float rstd = 1.0f / sqrtf(ss * (1.0f / 1024.0f) + 1e-6f);
                bf16_t* rowp = O + (size_t)row * 3072 + col0;
#pragma unroll
                for (int bj = 0; bj < 2; ++bj) { const f32x4 v0 = acc[ai][bj][m][0] * rstd, v1 = acc[ai][bj][m][1] * rstd;
                    u32x4 w; w.x = cvt_pk_bf16(v0[0], v0[1]); w.y = cvt_pk_bf16(v0[2], v0[3]); w.z = cvt_pk_bf16(v1[0], v1[1]); w.w = cvt_pk_bf16(v1[2], v1[3]);
                    *(u32x4*)(rowp + bj * HALF) = w; }
            }
    }
};
struct EpiRes {
    static constexpr bool PERM = false, AFTER_DRAIN = false;
    const float* base; float* xo; bf16_t* xb; float* rowss;
    __device__ __forceinline__ void operator()(const f32x4 (&acc)[2][2][4][2], const Unit& u, int wr, int wc, int fr, int fq) const {
        const int row0 = u.pm * BM + wr * 64 + fr, col0 = u.pn * BM + wc * 32 + 4 * fq;
#pragma unroll
        for (int ai = 0; ai < 2; ++ai)
#pragma unroll
            for (int m = 0; m < 4; ++m) {
                const int row = row0 + ai * HALF + m * 16; const size_t off = (size_t)row * 1024 + col0; float ss = 0.f;
#pragma unroll
                for (int bj = 0; bj < 2; ++bj)
#pragma unroll
                    for (int n = 0; n < 2; ++n) { const f32x4 bs = *(const f32x4*)(base + off + bj * HALF + n * 16); const f32x4 o = bs + acc[ai][bj][m][n];
                        *(f32x4*)(xo + off + bj * HALF + n * 16) = o; ss += (o[0] * o[0] + o[1] * o[1]) + (o[2] * o[2] + o[3] * o[3]);
                        if (xb) { typedef unsigned u32x2v __attribute__((ext_vector_type(2))); u32x2v w; w.x = cvt_pk_bf16(o[0], o[1]); w.y = cvt_pk_bf16(o[2], o[3]); *(u32x2v*)(xb + off + bj * HALF + n * 16) = w; } }
                ss += __shfl_xor(ss, 16); ss += __shfl_xor(ss, 32);
                if (fq == 0) rowss[(size_t)row * 16 + u.pn * 4 + wc] = ss;
                asm volatile("" ::: "memory");
            }
    }
};
}

__device__ __forceinline__ f32x4 tile16(const LAS bf16* A, int lda, const LAS bf16* Bt, int ldb, int K, int lane) {
    const LAS bf16* ap = A + (lane & 15) * lda + 8 * (lane >> 4);
    const LAS bf16* bp = Bt + (lane & 15) * ldb + 8 * (lane >> 4);
    f32x4 acc = {0.f, 0.f, 0.f, 0.f};
    for (int k0 = 0; k0 < K; k0 += 32) {
        const bf16x8 a = *(const LAS bf16x8*)(ap + k0), b = *(const LAS bf16x8*)(bp + k0);
        acc = __builtin_amdgcn_mfma_f32_16x16x32_bf16(a, b, acc, 0, 0, 0);
    }
    return acc;
}

template <int NT>
__device__ __forceinline__ void small_unit(const bf16* A, const bf16* Bt, int wave, int lane, f32x4 (&acc)[NT]) {
    const bf16* ap = A + (size_t)(16 * wave + (lane & 15)) * 1024 + 8 * (lane >> 4);
    const bf16* bp = Bt + (size_t)(lane & 15) * 1024 + 8 * (lane >> 4);
#pragma unroll
    for (int n = 0; n < NT; ++n) acc[n] = (f32x4){0.f, 0.f, 0.f, 0.f};
#pragma unroll 4
    for (int ks = 0; ks < 32; ++ks) {
        const bf16x8 a = *(const bf16x8*)(ap + 32 * ks);
#pragma unroll
        for (int n = 0; n < NT; ++n) { const bf16x8 b = *(const bf16x8*)(bp + (size_t)n * 16 * 1024 + 32 * ks); acc[n] = __builtin_amdgcn_mfma_f32_16x16x32_bf16(b, a, acc[n], 0, 0, 0); }
    }
}

__device__ __forceinline__ void p0_transpose_item(const float* W, int ldw, int k0, int nsrc0, const float* ks, bf16* WT, int ldt, int ndst0, int nkeep, LAS float* scr, int lane) {
#pragma unroll 8
    for (int i = 0; i < 32; ++i) { const int kk = 2 * i + (lane >> 5); float v = W[(size_t)(k0 + kk) * ldw + nsrc0 + (lane & 31)]; if (ks) v *= ks[k0 + kk]; scr[kk * 33 + (lane & 31)] = v; }
    LDS_WAIT();
    const int c = lane & 7;
#pragma unroll
    for (int j = 0; j < 4; ++j) { const int n = (lane >> 3) + 8 * j; const LAS float* s = scr + (8 * c) * 33 + n;
        u32x4 o; o.x = pk2(s[0 * 33], s[1 * 33]); o.y = pk2(s[2 * 33], s[3 * 33]); o.z = pk2(s[4 * 33], s[5 * 33]); o.w = pk2(s[6 * 33], s[7 * 33]);
        if (n < nkeep) *(u32x4*)(WT + (size_t)(ndst0 + n) * ldt + k0 + 8 * c) = o; }
    LDS_WAIT();
}

__device__ __forceinline__ void p0_prologue(const Frame& F0, int parts) {
    const Frame F = fresh(F0);
    LAS float* scr = (LAS float*)(F.lds + F.wave * 16384);
    const int gw = F.bid * NWAVES + F.wave, NGW = F.G * NWAVES, lane = F.lane;
    constexpr int I_IN = 16 * 96, I_LRI = 16, I_OUT = 16 * 32, I_GLU = 4 * 8, PER_L = I_IN + I_LRI + I_OUT + I_GLU;
    if (parts & 1)
    for (int it = gw; it < 2 * PER_L; it += NGW) {
        const int l = it / PER_L; int r = it % PER_L;
        const float* win = INP(I_WIN) + (size_t)l * 1024 * NIN; const float* nw = INP(I_NORMW) + l * 1024;
        if (r < I_IN) { const int kb = r / 96, nb = r % 96, n0 = 32 * nb, ns = n0 < 2048 ? n0 : n0 + 16;
            p0_transpose_item(win, NIN, 64 * kb, ns, nw, P_WIN + (size_t)l * NPROJ * 1024, 1024, n0, 32, scr, lane); continue; } r -= I_IN;
        if (r < I_LRI) { p0_transpose_item(win, NIN, 64 * r, 2048, nw, P_WLR + (size_t)l * 16 * 1024, 1024, 0, 16, scr, lane); continue; } r -= I_LRI;
        if (r < I_OUT) { const int kb = r / 32, nb = r % 32;
            p0_transpose_item(INP(I_WOUT) + (size_t)l * 1024 * 1024, 1024, 64 * kb, 32 * nb, nullptr, P_WOUT + (size_t)l * 1024 * 1024, 1024, 32 * nb, 32, scr, lane); continue; } r -= I_OUT;
        { const int kb = r / 8, nb = r % 8;
            p0_transpose_item(INP(I_WGLU) + (size_t)l * 256 * 256, 256, 64 * kb, 32 * nb, nullptr, P_WGLU + (size_t)l * 256 * 256, 256, 32 * nb, 32, scr, lane); }
    }
    if (parts & 2)
    for (int m = gw; m < TT; m += NGW) {
        const float* xrow = m < TP ? INP(I_XP) + (size_t)m * DM : INP(I_XS) + (size_t)(m - TP) * DM;
        const f32x4* xr = (const f32x4*)xrow + lane;
        f32x4 v[4]; float s = 0.f;
#pragma unroll
        for (int j = 0; j < 4; ++j) { v[j] = xr[64 * j]; s += (v[j][0] * v[j][0] + v[j][1] * v[j][1]) + (v[j][2] * v[j][2] + v[j][3] * v[j][3]); }
        s = wave_sum(s);
        u32x2* o8 = (u32x2*)(P_XB + (size_t)m * DM) + lane;
#pragma unroll
        for (int j = 0; j < 4; ++j) { u32x2 w; w.x = pk2(v[j][0], v[j][1]); w.y = pk2(v[j][2], v[j][3]); o8[64 * j] = w; }
        if (m < TP) { if (lane < 16) P_ROWSS[(size_t)m * 16 + lane] = lane == 0 ? s : 0.f; }
        else { if (lane < 32) P_ROWSS_S[(size_t)(m - TP) * 32 + lane] = lane == 0 ? s : 0.f; }
    }
    const int gt = F.bid * 512 + F.tid, NGT = F.G * 512;
    if (parts & 4)
    for (int i = gt; i < 2 * 16 * 64; i += NGT) {
        const int l = i >> 10, g = (i >> 6) & 15, p = i & 63;
        const float lr = INP(I_LAMRE)[i], li = INP(I_LAMIM)[i], step = expf(INP(I_LOGSTEP)[l * 16 + g]);
        const float mag = expf(lr * step), are = mag * cosf(li * step), aim = mag * sinf(li * step);
        const float den = lr * lr + li * li, nr = are - 1.0f;
        const float fre = (nr * lr + aim * li) / den, fim = (aim * lr - nr * li) / den;
        const float m64 = expf(lr * step * 64.f), a64r = m64 * cosf(li * step * 64.f), a64i = m64 * sinf(li * step * 64.f);
        float* sa = P_S5A + (size_t)i * 4; sa[0] = are; sa[1] = aim; sa[2] = a64r; sa[3] = a64i;
        const float* bre = INP(I_BRE) + (size_t)i * 16; const float* bim = INP(I_BIM) + (size_t)i * 16;
        bf16* bb = P_BBT + (size_t)(l * 16 + g) * 128 * 16;
        for (int c = 0; c < 16; ++c) { const float br = bre[c], bi = bim[c];
            bb[(p) * 16 + c] = (bf16)f2bf(fre * br - fim * bi); bb[(64 + p) * 16 + c] = (bf16)f2bf(fre * bi + fim * br); }
        const float* cre = INP(I_CRE) + (size_t)(l * 16 + g) * 16 * 64; const float* cim = INP(I_CIM) + (size_t)(l * 16 + g) * 16 * 64;
        bf16* cc = P_CCN + (size_t)(l * 16 + g) * 16 * 128;
        for (int c = 0; c < 16; ++c) { cc[c * 128 + p] = (bf16)f2bf(cre[c * 64 + p]); cc[c * 128 + 64 + p] = (bf16)f2bf(-cim[c * 64 + p]); }
    }
    if (parts & 4)
    for (int i = gt; i < 256; i += NGT) { const float l0 = INP(I_LBLOG)[i], l1 = INP(I_LBLOG)[256 + i]; P_LB[i] = 0.f; P_LB[256 + i] = 1.0f / (1.0f + expf(l0 - l1)); }
    if (parts & 4)
    for (int i = gt; i < 2049 * 16; i += NGT) { const int pos = i >> 4, j = i & 15; const float inv = powf(10000.0f, -(float)j / 16.0f);
        const float ang = (pos < 2048 ? (float)pos : (float)POS_S) * inv; P_ROT[i] = cosf(ang); P_ROT[2049 * 16 + i] = sinf(ang); }
}

__device__ __forceinline__ float rstd_prompt(const Frame& F, int row) {
    const f32x4* rp = (const f32x4*)(P_ROWSS + (size_t)row * 16); const f32x4 p0 = rp[0], p1 = rp[1], p2 = rp[2], p3 = rp[3];
    const float ss = ((p0[0] + p0[1]) + (p0[2] + p0[3])) + ((p1[0] + p1[1]) + (p1[2] + p1[3])) + ((p2[0] + p2[1]) + (p2[2] + p2[3])) + ((p3[0] + p3[1]) + (p3[2] + p3[3]));
    return 1.0f / sqrtf(ss * (1.0f / 1024.0f) + EPS);
}
__device__ __forceinline__ float rstd_sample(const Frame& F, int srow) {
    const f32x4* rp = (const f32x4*)(P_ROWSS_S + (size_t)srow * 32); float ss = 0.f;
#pragma unroll
    for (int i = 0; i < 8; ++i) { const f32x4 p = rp[i]; ss += (p[0] + p[1]) + (p[2] + p[3]); }
    return 1.0f / sqrtf(ss * (1.0f / 1024.0f) + EPS);
}
constexpr int N_G1_SMALL = 129 + 96;
__device__ __forceinline__ void g1_small_unit(const Frame& F0, int l, int u) {
    const Frame F = fresh(F0);
    const int wave = F.wave, lane = F.lane, r = lane & 15, q = lane >> 4;
    if (u <= 128) {
        const int row0 = u * 128;
        f32x4 acc[1];
        small_unit<1>(P_XB + (size_t)row0 * 1024, P_WLR + (size_t)l * 16 * 1024, wave, lane, acc);
        const int row = row0 + 16 * wave + r;
        const float rs = row < TP ? rstd_prompt(F, row) : rstd_sample(F, row - TP);
        *(f32x4*)(P_LR + (size_t)row * 16 + 4 * q) = acc[0] * rs;
    } else {
        const int c0 = (u - 129) * 32;
        f32x4 acc[2];
        small_unit<2>(P_XB + (size_t)TP * 1024, P_WIN + (size_t)l * NPROJ * 1024 + (size_t)c0 * 1024, wave, lane, acc);
        const int srow = 16 * wave + r; const float rs = rstd_sample(F, srow);
#pragma unroll
        for (int n = 0; n < 2; ++n) { const f32x4 v = acc[n] * rs; u32x2 w; w.x = pk2(v[0], v[1]); w.y = pk2(v[2], v[3]);
            *(u32x2*)(P_PROJ + (size_t)(TP + srow) * NPROJ + c0 + 16 * n + 4 * q) = w; }
    }
}
__device__ __forceinline__ void g2_small_unit(const Frame& F0, int l, int u) {
    const Frame F = fresh(F0);
    const int wave = F.wave, lane = F.lane, r = lane & 15, q = lane >> 4, c0 = u * 32;
    f32x4 acc[2];
    small_unit<2>(P_MIX + (size_t)TP * 1024, P_WOUT + (size_t)l * 1024 * 1024 + (size_t)c0 * 1024, wave, lane, acc);
    const int srow = 16 * wave + r;
    const float* base = (l == 0 ? INP(I_XS) : OUTP + O_YS) + (size_t)srow * 1024;
    float* xo = OUTP + O_YS + (size_t)srow * 1024; float ss = 0.f;
#pragma unroll
    for (int n = 0; n < 2; ++n) { const int c = c0 + 16 * n + 4 * q; const f32x4 o = *(const f32x4*)(base + c) + acc[n];
        *(f32x4*)(xo + c) = o; ss += (o[0] * o[0] + o[1] * o[1]) + (o[2] * o[2] + o[3] * o[3]);
        if (l == 0) { u32x2 w; w.x = pk2(o[0], o[1]); w.y = pk2(o[2], o[3]); *(u32x2*)(P_XB + (size_t)(TP + srow) * 1024 + c) = w; } }
    ss += __shfl_xor(ss, 16); ss += __shfl_xor(ss, 32);
    if (q == 0) P_ROWSS_S[(size_t)srow * 32 + u] = ss;
}

template <int BR, int PH>
__device__ __forceinline__ void att_item(const Frame& F0, int l, int b, int ch, int h) {
    const Frame F = fresh(F0);
    constexpr int DK = (BR == 0) ? 64 : 32, NG = DK / 8, KS = DK + 64;
    constexpr int QOFF = BR == 0 ? C_HGQ : (BR == 1 ? C_GLQ : C_RTQ), KOFF = BR == 0 ? C_HGF : (BR == 1 ? C_GLK : C_RTK), VOFF = BR == 0 ? C_HGI : (BR == 1 ? C_GLV : C_RTV), ZOFF = BR == 0 ? C_HGZ : (BR == 1 ? C_GLZ : C_RTZ);
    constexpr int SOFF = BR == 0 ? 0 : (BR == 1 ? 16384 : 24576), DOFF = BR == 0 ? 0 : (BR == 1 ? 256 : 384);
    LAS unsigned char* L = F.lds;
    LAS float* GB = (LAS float*)(L + 0);
    LAS float* SEGT = (LAS float*)(L + 16384);
    LAS bf16* A1 = (LAS bf16*)(L + 20480);
    LAS bf16* B1 = (LAS bf16*)(L + 37888);
    LAS bf16* QH = (LAS bf16*)(L + 55296);
    LAS bf16* KH = (LAS bf16*)(L + 64512);
    LAS float* OB = (LAS float*)(L + 55296);
    LAS bf16* KT = (LAS bf16*)(L + 87552);
    LAS bf16* VT = (LAS bf16*)(L + 96768);
    const int tid = F.tid, lane = F.lane, wave = F.wave;
    const size_t row0 = (size_t)b * SEQ + (size_t)ch * CH;
    const bf16* proj = P_PROJ;
    bsync();
    const bool act = tid < 64 * NG;
    const int t = tid / NG, kg = tid % NG;
    float qv[8], kv[8], gv[8];
    if (act) {
        const bf16* pr = proj + (row0 + t) * NPROJ;
        if (BR == 0) {
            const bf16x8 qq = *(const bf16x8*)(pr + QOFF + h * 64 + 8 * kg), ff = *(const bf16x8*)(pr + KOFF + h * 64 + 8 * kg);
            const float* lbp = P_LB + l * 256 + h * 64 + 8 * kg;
#pragma unroll
            for (int j = 0; j < 8; ++j) { const float x = bf2f(ff[j]), lb = lbp[j], sg = 1.0f / (1.0f + expf(-x)), f = lb + (1.0f - lb) * sg;
                gv[j] = fmaxf(logf(f), -60.f); kv[j] = (1.0f - lb) / (1.0f + expf(x)); qv[j] = bf2f(qq[j]); }
        } else if (BR == 1) {
            const bf16x8 qq = *(const bf16x8*)(pr + QOFF + h * 32 + 8 * kg), kk = *(const bf16x8*)(pr + KOFF + h * 32 + 8 * kg);
            const f32x4* lrp = (const f32x4*)(P_LR + (row0 + t) * 16);
            const f32x4 l0 = lrp[0], l1 = lrp[1], l2 = lrp[2], l3 = lrp[3];
            const float lrv[16] = {l0[0], l0[1], l0[2], l0[3], l1[0], l1[1], l1[2], l1[3], l2[0], l2[1], l2[2], l2[3], l3[0], l3[1], l3[2], l3[3]};
            const float* wup = INP(I_GLWUP) + (size_t)l * 16 * 128 + h * 32 + 8 * kg; const float* bg = INP(I_GLB) + l * 128 + h * 32 + 8 * kg;
            float pre[8];
#pragma unroll
            for (int j = 0; j < 8; ++j) pre[j] = bg[j];
#pragma unroll
            for (int r = 0; r < 16; ++r) { const f32x4 w0 = *(const f32x4*)(wup + r * 128), w1 = *(const f32x4*)(wup + r * 128 + 4);
#pragma unroll
                for (int j = 0; j < 4; ++j) { pre[j] += lrv[r] * w0[j]; pre[4 + j] += lrv[r] * w1[j]; } }
#pragma unroll
            for (int j = 0; j < 8; ++j) { gv[j] = logsigmoidf_(pre[j]) * (1.0f / 16.0f); qv[j] = bf2f(qq[j]) * 0.17677669529663687f; kv[j] = bf2f(kk[j]); }
        } else {
            const bf16x8 qo = *(const bf16x8*)(pr + QOFF + h * 32 + 8 * kg), qp = *(const bf16x8*)(pr + QOFF + h * 32 + 8 * (kg ^ 2));
            const bf16x8 ko = *(const bf16x8*)(pr + KOFF + h * 32 + 8 * kg), kp = *(const bf16x8*)(pr + KOFF + h * 32 + 8 * (kg ^ 2));
            const int pos = ch * CH + t;
            const float* rc = P_ROT + (size_t)pos * 16 + 8 * (kg & 1); const float* rsn = P_ROT + 2049 * 16 + (size_t)pos * 16 + 8 * (kg & 1);
            const float lg = log1pf(-exp2f(-5.0f - (float)h));
#pragma unroll
            for (int j = 0; j < 8; ++j) { const float c = rc[j], s = rsn[j], a = bf2f(qo[j]), pq = bf2f(qp[j]), bk = bf2f(ko[j]), pk = bf2f(kp[j]);
                qv[j] = kg < 2 ? a * c - pq * s : pq * s + a * c;
                kv[j] = (kg < 2 ? bk * c - pk * s : pk * s + bk * c) * 0.17677669529663687f; gv[j] = lg; }
        }
        *(f32x4*)(GB + t * DK + 8 * kg) = (f32x4){gv[0], gv[1], gv[2], gv[3]}; *(f32x4*)(GB + t * DK + 8 * kg + 4) = (f32x4){gv[4], gv[5], gv[6], gv[7]};
    }
    bsync();
    {
        constexpr int RPS = DK / 8;
        const int k = tid % DK, seg = tid / DK; float s = 0.f;
#pragma unroll
        for (int r = 0; r < RPS; ++r) { const int idx = (seg * RPS + r) * DK + k; s += GB[idx]; GB[idx] = s; }
        SEGT[seg * DK + k] = s;
        bsync();
        float pre = 0.f;
        for (int s2 = 0; s2 < seg; ++s2) pre += SEGT[s2 * DK + k];
#pragma unroll
        for (int r = 0; r < RPS; ++r) { const int idx = (seg * RPS + r) * DK + k; GB[idx] += pre; }
    }
    bsync();
    const int tv = tid >> 3, vg = tid & 7;
    const bf16x8 vv = *(const bf16x8*)(proj + (row0 + tv) * NPROJ + VOFF + h * 64 + 8 * vg);
    float* sl = P_SLOC + ((size_t)(b * NCH + ch) * 32768 + SOFF + (size_t)h * DK * 64);
    if (PH == 2) {
        if (act) {
            const f32x4 b0 = *(const LAS f32x4*)(GB + t * DK + 8 * kg), b1 = *(const LAS f32x4*)(GB + t * DK + 8 * kg + 4);
            const f32x4 e0 = *(const LAS f32x4*)(GB + 63 * DK + 8 * kg), e1 = *(const LAS f32x4*)(GB + 63 * DK + 8 * kg + 4);
            const float bt[8] = {b0[0], b0[1], b0[2], b0[3], b1[0], b1[1], b1[2], b1[3]}, bl[8] = {e0[0], e0[1], e0[2], e0[3], e1[0], e1[1], e1[2], e1[3]};
#pragma unroll
            for (int j = 0; j < 8; ++j) KT[(8 * kg + j) * 72 + t] = (bf16)f2bf(kv[j] * expf(bl[j] - bt[j]));
        }
#pragma unroll
        for (int j = 0; j < 8; ++j) VT[(8 * vg + j) * 72 + tv] = (bf16)vv[j];
        if (tid < DK) P_DEC[(size_t)(b * NCH + ch) * 512 + DOFF + h * DK + tid] = expf(GB[63 * DK + tid]);
        bsync();
        constexpr int NTL = (DK / 16) * 4;
        for (int T = wave; T < NTL; T += 8) { const int ki = T >> 2, vj = T & 3;
            const f32x4 d = tile16(KT + 16 * ki * 72, 72, VT + 16 * vj * 72, 72, 64, lane);
#pragma unroll
            for (int r = 0; r < 4; ++r) sl[(16 * ki + 4 * (lane >> 4) + r) * 64 + 16 * vj + (lane & 15)] = d[r]; }
    } else {
        if (act) {
            const f32x4 b0 = *(const LAS f32x4*)(GB + t * DK + 8 * kg), b1 = *(const LAS f32x4*)(GB + t * DK + 8 * kg + 4);
            const float bt[8] = {b0[0], b0[1], b0[2], b0[3], b1[0], b1[1], b1[2], b1[3]};
            const int it = t >> 4; float o8[8];
#pragma unroll
            for (int j = 0; j < 8; ++j) o8[j] = qv[j] * expf(bt[j]);
            *(LAS u32x4*)(A1 + t * 136 + 8 * kg) = pack8(o8);
#pragma unroll
            for (int i = 0; i < 4; ++i) {
                if (i >= it) {
                    float br[8];
                    if (i == 0) {
#pragma unroll
                        for (int j = 0; j < 8; ++j) br[j] = 0.f;
                    } else { const f32x4 r0 = *(const LAS f32x4*)(GB + (16 * i - 1) * DK + 8 * kg), r1 = *(const LAS f32x4*)(GB + (16 * i - 1) * DK + 8 * kg + 4);
                        br[0] = r0[0]; br[1] = r0[1]; br[2] = r0[2]; br[3] = r0[3]; br[4] = r1[0]; br[5] = r1[1]; br[6] = r1[2]; br[7] = r1[3]; }
                    if (i == it) {
#pragma unroll
                        for (int j = 0; j < 8; ++j) o8[j] = qv[j] * expf(bt[j] - br[j]);
                        *(LAS u32x4*)(QH + t * 72 + 8 * kg) = pack8(o8);
                    }
#pragma unroll
                    for (int j = 0; j < 8; ++j) o8[j] = kv[j] * expf(fminf(br[j] - bt[j], 80.f));
                    *(LAS u32x4*)(KH + (8 * i * (i + 1) + t) * 72 + 8 * kg) = pack8(o8);
                }
            }
        }
#pragma unroll
        for (int j = 0; j < 8; ++j) B1[(8 * vg + j) * 136 + DK + tv] = (bf16)vv[j];
        for (int idx = tid; idx < DK * 64; idx += 512) { const int k = idx >> 6, v = idx & 63; B1[v * 136 + k] = (bf16)f2bf(sl[idx]); }
        bsync();
#pragma unroll
        for (int e = 0; e < 2; ++e) { const int T = 2 * wave + e, i = T >> 2, j = T & 3;
            f32x4 d = {0.f, 0.f, 0.f, 0.f};
            if (j <= i) d = tile16(QH + 16 * i * 72, 72, KH + (8 * i * (i + 1) + 16 * j) * 72, 72, DK, lane);
#pragma unroll
            for (int r = 0; r < 4; ++r) { const int tt = 4 * (lane >> 4) + r, ss = lane & 15; const float val = (j < i || (j == i && ss <= tt)) ? d[r] : 0.f;
                A1[(16 * i + tt) * 136 + DK + 16 * j + ss] = (bf16)f2bf(val); } }
        bsync();
#pragma unroll
        for (int e = 0; e < 2; ++e) { const int T = 2 * wave + e, ti = T >> 2, vj = T & 3;
            const f32x4 d = tile16(A1 + 16 * ti * 136, 136, B1 + 16 * vj * 136, 136, KS, lane);
#pragma unroll
            for (int r = 0; r < 4; ++r) OB[(16 * ti + 4 * (lane >> 4) + r) * 68 + 16 * vj + (lane & 15)] = d[r]; }
        bsync();
        {
            const int tr = tid >> 3, sg = tid & 7;
            const f32x4 o0 = *(const LAS f32x4*)(OB + tr * 68 + 8 * sg), o1 = *(const LAS f32x4*)(OB + tr * 68 + 8 * sg + 4);
            float o[8] = {o0[0], o0[1], o0[2], o0[3], o1[0], o1[1], o1[2], o1[3]};
            if (BR == 2) { float s = 0.f;
#pragma unroll
                for (int j = 0; j < 8; ++j) s += o[j];
                s += __shfl_xor(s, 1); s += __shfl_xor(s, 2); s += __shfl_xor(s, 4);
                const float mean = s * (1.0f / 64.0f);
#pragma unroll
                for (int j = 0; j < 8; ++j) o[j] -= mean; }
            float ss = 0.f;
#pragma unroll
            for (int j = 0; j < 8; ++j) ss += o[j] * o[j];
            ss += __shfl_xor(ss, 1); ss += __shfl_xor(ss, 2); ss += __shfl_xor(ss, 4);
            const float rstd = 1.0f / sqrtf(ss * (1.0f / 64.0f) + EPS);
            const float* nw = INP(BR == 0 ? I_HGNW : (BR == 1 ? I_GLNW : I_RTNW)) + l * 256 + h * 64 + 8 * sg;
            const bf16x8 zz = *(const bf16x8*)(proj + (row0 + tr) * NPROJ + ZOFF + h * 64 + 8 * sg);
#pragma unroll
            for (int j = 0; j < 8; ++j) o[j] = o[j] * rstd * nw[j] * siluf_(bf2f(zz[j]));
            *(u32x4*)(P_MIX + (row0 + tr) * 1024 + 256 * (BR + 1) + h * 64 + 8 * sg) = pack8(o);
        }
    }
}

__device__ __forceinline__ int s5idx(int t, int n) { return t * 128 + ((((n >> 3) ^ (t & 7))) << 3) + (n & 7); }
template <int PH>
__device__ __forceinline__ void s5_item(const Frame& F0, int l, int b, int ch) {
    const Frame F = fresh(F0);
    LAS unsigned char* L = F.lds;
    const int lane = F.lane, wave = F.wave;
    LAS bf16* SR = (LAS bf16*)(L + wave * 16384);
    const size_t row0 = (size_t)b * SEQ + (size_t)ch * CH;
    const bf16* proj = P_PROJ;
    bsync();
    f32x4 yacc[2][4];
#pragma unroll
    for (int rd = 0; rd < 2; ++rd) {
        const int g = wave + 8 * rd;
        const bf16* bbt = P_BBT + (size_t)(l * 16 + g) * 128 * 16;
#pragma unroll
        for (int tt = 0; tt < 2; ++tt) {
            const bf16x8 a = *(const bf16x8*)(proj + (row0 + 32 * tt + (lane & 31)) * NPROJ + C_S5U + 16 * g + 8 * (lane >> 5));
#pragma unroll
            for (int nn = 0; nn < 4; ++nn) {
                const bf16x8 bq = *(const bf16x8*)(bbt + (32 * nn + (lane & 31)) * 16 + 8 * (lane >> 5));
                f32x16 d;
#pragma unroll
                for (int i = 0; i < 16; ++i) d[i] = 0.f;
                d = __builtin_amdgcn_mfma_f32_32x32x16_bf16(a, bq, d, 0, 0, 0);
#pragma unroll
                for (int i = 0; i < 16; ++i) { const int tr = 32 * tt + (i & 3) + 8 * (i >> 2) + 4 * (lane >> 5), n = 32 * nn + (lane & 31); SR[s5idx(tr, n)] = (bf16)f2bf(d[i]); }
            }
        }
        LDS_WAIT();
        {
            const f32x4 av = *(const f32x4*)(P_S5A + (size_t)((l * 16 + g) * 64 + lane) * 4);
            const float ar = av[0], ai = av[1];
            float* s5l = P_S5LOC + ((size_t)(b * NCH + ch) * 16 + g) * 128 + 2 * lane;
            float sr = 0.f, si = 0.f;
            if (PH == 4) { const f32x2 s0 = *(const f32x2*)s5l; sr = s0[0]; si = s0[1]; }
            for (int t = 0; t < 64; ++t) {
                const int i0 = s5idx(t, lane), i1 = s5idx(t, 64 + lane);
                const float br = bf2f((short)SR[i0]), bi = bf2f((short)SR[i1]);
                const float nr = ar * sr - ai * si + br, ni = ar * si + ai * sr + bi; sr = nr; si = ni;
                if (PH == 4) { SR[i0] = (bf16)f2bf(sr); SR[i1] = (bf16)f2bf(si); }
            }
            if (PH == 2) *(f32x2*)s5l = (f32x2){sr, si};
        }
        if (PH == 4) {
            LDS_WAIT();
            const bf16* ccn = P_CCN + (size_t)(l * 16 + g) * 16 * 128;
            bf16x8 bfr[4];
#pragma unroll
            for (int ks = 0; ks < 4; ++ks) bfr[ks] = *(const bf16x8*)(ccn + (lane & 15) * 128 + 32 * ks + 8 * (lane >> 4));
#pragma unroll
            for (int ti = 0; ti < 4; ++ti) { f32x4 acc = {0.f, 0.f, 0.f, 0.f};
#pragma unroll
                for (int ks = 0; ks < 4; ++ks) { const bf16x8 afr = *(const LAS bf16x8*)(SR + s5idx(16 * ti + (lane & 15), 32 * ks + 8 * (lane >> 4)));
                    acc = __builtin_amdgcn_mfma_f32_16x16x32_bf16(bfr[ks], afr, acc, 0, 0, 0); }
                yacc[rd][ti] = acc; }
            LDS_WAIT();
        }
    }
    if (PH == 4) {
        bsync();
        LAS bf16* YB = (LAS bf16*)L;
#pragma unroll
        for (int rd = 0; rd < 2; ++rd) { const int g = wave + 8 * rd;
#pragma unroll
            for (int ti = 0; ti < 4; ++ti) { const int t = 16 * ti + (lane & 15), c0 = 16 * g + 4 * (lane >> 4);
                const bf16x4 u4 = *(const bf16x4*)(proj + (row0 + t) * NPROJ + C_S5U + c0);
                const f32x4 dsk = *(const f32x4*)(INP(I_S5D) + l * 256 + c0);
                float y[4];
#pragma unroll
                for (int j = 0; j < 4; ++j) y[j] = gelu_tanh(yacc[rd][ti][j] + dsk[j] * bf2f(u4[j]));
                u32x2 w; w.x = pk2(y[0], y[1]); w.y = pk2(y[2], y[3]);
                *(LAS u32x2*)(YB + t * 264 + c0) = w; } }
        bsync();
        const bf16* wg = P_WGLU + (size_t)l * 256 * 256;
#pragma unroll
        for (int nt = 0; nt < 2; ++nt) { const int ntile = 2 * wave + nt;
            f32x4 acc[4];
#pragma unroll
            for (int ti = 0; ti < 4; ++ti) acc[ti] = (f32x4){0.f, 0.f, 0.f, 0.f};
#pragma unroll 2
            for (int ks = 0; ks < 8; ++ks) {
                const bf16x8 bfr = *(const bf16x8*)(wg + (size_t)(16 * ntile + (lane & 15)) * 256 + 32 * ks + 8 * (lane >> 4));
#pragma unroll
                for (int ti = 0; ti < 4; ++ti) { const bf16x8 afr = *(const LAS bf16x8*)(YB + (16 * ti + (lane & 15)) * 264 + 32 * ks + 8 * (lane >> 4));
                    acc[ti] = __builtin_amdgcn_mfma_f32_16x16x32_bf16(bfr, afr, acc[ti], 0, 0, 0); }
            }
#pragma unroll
            for (int ti = 0; ti < 4; ++ti) {
                const int t = 16 * ti + (lane & 15), n0 = 16 * ntile + 4 * (lane >> 4);
                const bf16x4 y4 = *(const LAS bf16x4*)(YB + t * 264 + n0);
                const bf16x4 z4 = *(const bf16x4*)(proj + (row0 + t) * NPROJ + C_S5Z + n0);
                float o[4];
#pragma unroll
                for (int j = 0; j < 4; ++j) o[j] = bf2f(y4[j]) * sigmoidf_(acc[ti][j]) * siluf_(bf2f(z4[j]));
                u32x2 w; w.x = pk2(o[0], o[1]); w.y = pk2(o[2], o[3]);
                *(u32x2*)(P_MIX + (row0 + t) * 1024 + n0) = w; } }
    }
}

__device__ __forceinline__ void p3_carry(const Frame& F0, int l) {
    const Frame F = fresh(F0);
    const int gt = F.bid * 512 + F.tid, NGT = F.G * 512;
    for (int e = gt; e < NBATCH * 32768; e += NGT) {
        const int b = e >> 15, r = e & 32767;
        int di; size_t oo;
        if (r < 16384) { di = r >> 6; oo = O_HG_P + (size_t)(l * 8 + b) * 16384 + r; }
        else if (r < 24576) { di = 256 + ((r - 16384) >> 6); oo = O_GLA_P + (size_t)(l * 8 + b) * 8192 + (r - 16384); }
        else { di = 384 + ((r - 24576) >> 6); oo = O_RET_P + (size_t)(l * 8 + b) * 8192 + (r - 24576); }
        float* sp = P_SLOC + (size_t)b * NCH * 32768 + r; const float* dp = P_DEC + (size_t)b * NCH * 512 + di;
        float S = 0.f;
        for (int c0 = 0; c0 < NCH; c0 += 8) {
            float hv[8], dv[8];
#pragma unroll
            for (int c = 0; c < 8; ++c) { hv[c] = sp[(size_t)(c0 + c) * 32768]; dv[c] = dp[(size_t)(c0 + c) * 512]; }
#pragma unroll
            for (int c = 0; c < 8; ++c) { sp[(size_t)(c0 + c) * 32768] = S; S = dv[c] * S + hv[c]; }
        }
        OUTP[oo] = S;
    }
    for (int e = gt; e < NBATCH * 1024; e += NGT) {
        const int b = e >> 10, gp = e & 1023;
        const f32x4 av = *(const f32x4*)(P_S5A + (size_t)(l * 1024 + gp) * 4); const float a64r = av[2], a64i = av[3];
        float* sp = P_S5LOC + (size_t)b * NCH * 2048 + 2 * gp;
        float sr = 0.f, si = 0.f;
        for (int c = 0; c < NCH; ++c) { const f32x2 hv = *(const f32x2*)(sp + (size_t)c * 2048); *(f32x2*)(sp + (size_t)c * 2048) = (f32x2){sr, si};
            const float nr = a64r * sr - a64i * si + hv[0], ni = a64r * si + a64i * sr + hv[1]; sr = nr; si = ni; }
        OUTP[O_S5RE_P + (size_t)(l * 8 + b) * 1024 + gp] = sr; OUTP[O_S5IM_P + (size_t)(l * 8 + b) * 1024 + gp] = si;
    }
}

template <int BR>
__device__ __forceinline__ void samp_att_item(const Frame& F0, int l, int sb, int h) {
    const Frame F = fresh(F0);
    constexpr int DK = (BR == 0) ? 64 : 32, KPS = DK / 8;
    constexpr int QOFF = BR == 0 ? C_HGQ : (BR == 1 ? C_GLQ : C_RTQ), KOFF = BR == 0 ? C_HGF : (BR == 1 ? C_GLK : C_RTK), VOFF = BR == 0 ? C_HGI : (BR == 1 ? C_GLV : C_RTV), ZOFF = BR == 0 ? C_HGZ : (BR == 1 ? C_GLZ : C_RTZ);
    LAS float* QS = (LAS float*)(F.lds + 0);
    LAS float* KSV = (LAS float*)(F.lds + 256);
    LAS float* EG = (LAS float*)(F.lds + 512);
    LAS float* VS = (LAS float*)(F.lds + 768);
    LAS float* PART = (LAS float*)(F.lds + 1024);
    const int tid = F.tid;
    const bf16* pr = P_PROJ + (size_t)(TP + sb) * NPROJ;
    bsync();
    if (tid < DK) {
        const int c = tid;
        if (BR == 0) { const float x = bf2f((short)pr[KOFF + h * 64 + c]), lb = P_LB[l * 256 + h * 64 + c], sg = 1.0f / (1.0f + expf(-x));
            EG[c] = lb + (1.0f - lb) * sg; KSV[c] = (1.0f - lb) / (1.0f + expf(x)); QS[c] = bf2f((short)pr[QOFF + h * 64 + c]); }
        else if (BR == 1) { const float* lrp = P_LR + (size_t)(TP + sb) * 16; float pre = INP(I_GLB)[l * 128 + h * 32 + c];
            for (int r = 0; r < 16; ++r) pre += lrp[r] * INP(I_GLWUP)[(size_t)l * 16 * 128 + r * 128 + h * 32 + c];
            EG[c] = expf(logsigmoidf_(pre) * (1.0f / 16.0f)); QS[c] = bf2f((short)pr[QOFF + h * 32 + c]) * 0.17677669529663687f; KSV[c] = bf2f((short)pr[KOFF + h * 32 + c]); }
        else { const int j = c & 15; const float cs = P_ROT[2048 * 16 + j], sn = P_ROT[2049 * 16 + 2048 * 16 + j];
            const float q1 = bf2f((short)pr[QOFF + h * 32 + j]), q2 = bf2f((short)pr[QOFF + h * 32 + 16 + j]), k1 = bf2f((short)pr[KOFF + h * 32 + j]), k2 = bf2f((short)pr[KOFF + h * 32 + 16 + j]);
            QS[c] = c < 16 ? q1 * cs - q2 * sn : q1 * sn + q2 * cs; KSV[c] = (c < 16 ? k1 * cs - k2 * sn : k1 * sn + k2 * cs) * 0.17677669529663687f;
            EG[c] = 1.0f - exp2f(-5.0f - (float)h); }
    }
    if (tid >= 64 && tid < 128) VS[tid - 64] = bf2f((short)pr[VOFF + h * 64 + (tid - 64)]);
    bsync();
    const int v = tid & 63, ksl = tid >> 6;
    const size_t sbase = ((size_t)(l * NS + sb) * 4 + h) * DK * 64;
    const float* s0 = INP(BR == 0 ? I_SHG : (BR == 1 ? I_SGLA : I_SRET)) + sbase;
    float* s1 = OUTP + (BR == 0 ? O_HG_S : (BR == 1 ? O_GLA_S : O_RET_S)) + sbase;
    float acc = 0.f; const float vvv = VS[v];
#pragma unroll
    for (int kk = 0; kk < KPS; ++kk) { const int k = ksl * KPS + kk; const float sn = EG[k] * s0[k * 64 + v] + KSV[k] * vvv; s1[k * 64 + v] = sn; acc += QS[k] * sn; }
    PART[ksl * 64 + v] = acc;
    bsync();
    if (tid < 64) {
        float o = 0.f;
#pragma unroll
        for (int s = 0; s < 8; ++s) o += PART[s * 64 + tid];
        if (BR == 2) o -= wave_sum(o) * (1.0f / 64.0f);
        const float rstd = 1.0f / sqrtf(wave_sum(o * o) * (1.0f / 64.0f) + EPS);
        const float nw = INP(BR == 0 ? I_HGNW : (BR == 1 ? I_GLNW : I_RTNW))[l * 256 + h * 64 + tid];
        const float z = bf2f((short)pr[ZOFF + h * 64 + tid]);
        P_MIX[(size_t)(TP + sb) * 1024 + 256 * (BR + 1) + h * 64 + tid] = (bf16)f2bf(o * rstd * nw * siluf_(z));
    }
}
__device__ __forceinline__ void samp_s5_item(const Frame& F0, int l, int sb) {
    const Frame F = fresh(F0);
    LAS float* US = (LAS float*)(F.lds + 0);
    LAS float* SS = (LAS float*)(F.lds + 1024);
    LAS float* YS = (LAS float*)(F.lds + 1024 + 8192);
    const int tid = F.tid;
    const bf16* pr = P_PROJ + (size_t)(TP + sb) * NPROJ;
    bsync();
    if (tid < 256) US[tid] = bf2f((short)pr[C_S5U + tid]);
    bsync();
    for (int idx = tid; idx < 1024; idx += 512) { const int g = idx >> 6, p = idx & 63;
        const bf16* bb = P_BBT + (size_t)(l * 16 + g) * 128 * 16; float br = 0.f, bi = 0.f;
#pragma unroll
        for (int c = 0; c < 16; ++c) { const float u = US[16 * g + c]; br += bf2f((short)bb[p * 16 + c]) * u; bi += bf2f((short)bb[(64 + p) * 16 + c]) * u; }
        const f32x4 av = *(const f32x4*)(P_S5A + (size_t)(l * 1024 + idx) * 4);
        const size_t si = (size_t)(l * NS + sb) * 1024 + idx;
        const float s0r = INP(I_S5RE)[si], s0i = INP(I_S5IM)[si];
        const float nr = av[0] * s0r - av[1] * s0i + br, ni = av[0] * s0i + av[1] * s0r + bi;
        OUTP[O_S5RE_S + si] = nr; OUTP[O_S5IM_S + si] = ni; SS[g * 128 + p] = nr; SS[g * 128 + 64 + p] = ni; }
    bsync();
    if (tid < 256) { const int g = tid >> 4, c = tid & 15; const bf16* cc = P_CCN + (size_t)(l * 16 + g) * 16 * 128 + c * 128; float y = 0.f;
        for (int n = 0; n < 128; ++n) y += bf2f((short)cc[n]) * SS[g * 128 + n];
        YS[tid] = gelu_tanh(y + INP(I_S5D)[l * 256 + tid] * US[tid]); }
    bsync();
    if (tid < 256) { const bf16* wg = P_WGLU + (size_t)l * 256 * 256 + (size_t)tid * 256; float gl = 0.f;
        for (int c8 = 0; c8 < 32; ++c8) { const bf16x8 w = *(const bf16x8*)(wg + 8 * c8);
#pragma unroll
            for (int j = 0; j < 8; ++j) gl += bf2f(w[j]) * YS[8 * c8 + j]; }
        const float z = bf2f((short)pr[C_S5Z + tid]);
        P_MIX[(size_t)(TP + sb) * 1024 + tid] = (bf16)f2bf(YS[tid] * sigmoidf_(gl) * siluf_(z)); }
}

__device__ __forceinline__ void final_norm(const Frame& F0) {
    const Frame F = fresh(F0);
    const int gw = F.bid * NWAVES + F.wave, NGW = F.G * NWAVES, lane = F.lane;
    for (int m = gw; m < TT; m += NGW) {
        float* row = m < TP ? OUTP + O_YP + (size_t)m * DM : OUTP + O_YS + (size_t)(m - TP) * DM;
        f32x4* xr = (f32x4*)row + lane; f32x4 v[4]; float s = 0.f;
#pragma unroll
        for (int j = 0; j < 4; ++j) { v[j] = xr[64 * j]; s += (v[j][0] * v[j][0] + v[j][1] * v[j][1]) + (v[j][2] * v[j][2] + v[j][3] * v[j][3]); }
        const float rstd = 1.0f / sqrtf(wave_sum(s) * (1.0f / 1024.0f) + EPS);
        const f32x4* wr = (const f32x4*)INP(I_FNORMW) + lane;
#pragma unroll
        for (int j = 0; j < 4; ++j) xr[64 * j] = v[j] * rstd * wr[64 * j];
    }
}

__global__ void __launch_bounds__(NWAVES * 64, 2) __attribute__((target("no-packed-fp32-ops"))) mk_fwd(Args args) {
    extern __shared__ __attribute__((aligned(16))) unsigned char lds[];
    Frame F;
    F.lds = (LAS unsigned char*)lds;
    F.tid = threadIdx.x; F.lane = F.tid & 63; F.wave = __builtin_amdgcn_readfirstlane(F.tid >> 6); F.G = gridDim.x; F.bid = blockIdx.x; F.kp = (KargPtr)__builtin_amdgcn_kernarg_segment_ptr();
    unsigned char* ws = args.ws;
    volatile LAS unsigned* MISC = (volatile LAS unsigned*)(F.lds + MISC_OFF);
    for (int u = F.tid; u < (LDS_BYTES - LDSCTL_OFF) / 4; u += NWAVES * 64) ((LAS unsigned*)(F.lds + LDSCTL_OFF))[u] = 0u;
    bsync();
    unsigned* barw = (unsigned*)(ws + WS_CTL) + CW_BAR;
    XcdBarrier bar; bar.bar = barw; bar.x = 0; bar.st = nullptr;
    if (N_LAUNCHES == 1) bar = xcd_barrier_post(barw, MISC + 8);
    const int lo = args.ph_lo, hi = args.ph_hi;
#define IN(k) (lo <= (k) && (k) < hi)
#define SEAM(k) do { if (IN(k) && IN((k) + 1)) xcd_barrier(bar); } while (0)

    if (IN(0)) { p0_prologue(F, 7); if ((DUP_MASK) >> 7) p0_prologue(F, (DUP_MASK) >> 7); }
    SEAM(0);
#pragma unroll 1
    for (int l = 0; l < 2; ++l) {
        const int pb = 1 + 5 * l;
        if (IN(pb)) {
            pg8::Gemm g{P_XB, P_WIN + (size_t)l * NPROJ * 1024, TP, NPROJ, DM}; pg8::StaticOrder S; S.init(TP, NPROJ, F.G, F.bid);
            pg8::EpiProj E{P_PROJ, P_ROWSS};
            for (int rep = 0; rep < NREP(1); ++rep) pg8::gemm_phase<pg8::EpiProj, pg8::StaticOrder, true, true>(F.lds, g, S, E);
            for (int rep = 0; rep < NREP(5); ++rep) for (int u = F.bid; u < N_G1_SMALL; u += F.G) g1_small_unit(F, l, u);
        }
        SEAM(pb);
        if (IN(pb + 1)) {
            for (int rep = 0; rep < NREP(2); ++rep)
            for (int it = F.bid; it < NBC; it += F.G) { const int b = it / NCH, ch = it % NCH;
#pragma unroll 1
                for (int h = 0; h < 4; ++h) att_item<0, 2>(F, l, b, ch, h);
#pragma unroll 1
                for (int h = 0; h < 4; ++h) att_item<1, 2>(F, l, b, ch, h);
#pragma unroll 1
                for (int h = 0; h < 4; ++h) att_item<2, 2>(F, l, b, ch, h);
                s5_item<2>(F, l, b, ch); }
        }
        SEAM(pb + 1);
        if (IN(pb + 2)) p3_carry(F, l);
        SEAM(pb + 2);
        if (IN(pb + 3)) {
            for (int rep = 0; rep < NREP(3); ++rep)
            for (int it = F.bid; it < NBC; it += F.G) { const int b = it / NCH, ch = it % NCH;
#pragma unroll 1
                for (int h = 0; h < 4; ++h) att_item<0, 4>(F, l, b, ch, h);
#pragma unroll 1
                for (int h = 0; h < 4; ++h) att_item<1, 4>(F, l, b, ch, h);
#pragma unroll 1
                for (int h = 0; h < 4; ++h) att_item<2, 4>(F, l, b, ch, h);
                s5_item<4>(F, l, b, ch); }
            for (int rep = 0; rep < NREP(6); ++rep)
            for (int it = F.bid; it < NS * 13; it += F.G) { const int sb = it / 13, sub = it % 13;
                if (sub < 4) samp_att_item<0>(F, l, sb, sub); else if (sub < 8) samp_att_item<1>(F, l, sb, sub - 4); else if (sub < 12) samp_att_item<2>(F, l, sb, sub - 8); else samp_s5_item(F, l, sb); }
        }
        SEAM(pb + 3);
        if (IN(pb + 4)) {
            pg8::Gemm g{P_MIX, P_WOUT + (size_t)l * 1024 * 1024, TP, DM, DM}; pg8::StaticOrder S; S.init(TP, DM, F.G, F.bid);
            pg8::EpiRes E{l == 0 ? INP(I_XP) : OUTP + O_YP, OUTP + O_YP, l == 0 ? P_XB : nullptr, P_ROWSS};
            for (int rep = 0; rep < (l == 0 ? NREP(4) : 1); ++rep) pg8::gemm_phase<pg8::EpiRes, pg8::StaticOrder, false, true>(F.lds, g, S, E);
            for (int u = F.bid; u < 32; u += F.G) g2_small_unit(F, l, u);
        }
        SEAM(pb + 4);
    }
    if (IN(11)) final_norm(F);
#undef IN
#undef SEAM
}

extern "C" void kernel_launch(void* const* d_in, const int* in_sizes, int n_in, void* d_out, int out_size, void* d_ws, size_t ws_size, hipStream_t stream) {
    static int grid = 0;
    if (grid == 0) {
        if (n_in != N_INPUTS || in_sizes[0] != TP * DM || (size_t)out_size != O_END || ws_size < WS_END) { fprintf(stderr, "kernel_launch: unexpected shapes (n_in %d, in0 %d, out %d, ws %zu)\n", n_in, n_in > 0 ? in_sizes[0] : -1, out_size, ws_size); grid = -1; return; }
        int dev = 0, cus = 0, per_cu = 0;
        if (hipGetDevice(&dev) != hipSuccess || hipDeviceGetAttribute(&cus, hipDeviceAttributeMultiprocessorCount, dev) != hipSuccess) { grid = -1; return; }
        if (hipFuncSetAttribute((const void*)mk_fwd, hipFuncAttributeMaxDynamicSharedMemorySize, LDS_BYTES) != hipSuccess) { fprintf(stderr, "kernel_launch: hipFuncSetAttribute failed\n"); grid = -1; return; }
        if (hipOccupancyMaxActiveBlocksPerMultiprocessor(&per_cu, (const void*)mk_fwd, NWAVES * 64, LDS_BYTES) != hipSuccess || per_cu < 1) fprintf(stderr, "kernel_launch: occupancy query says %d\n", per_cu);
        (void)hipGetLastError();
        grid = cus < 256 ? cus : 256;
    }
    if (grid < 0) return;
    if (hipMemsetAsync((char*)d_ws + WS_CTL, 0, CTL_ZERO_BYTES, stream) != hipSuccess) return;
    Args a{};
    for (int i = 0; i < N_INPUTS; ++i) a.in[i] = (const float*)d_in[i];
    a.out = (float*)d_out; a.ws = (unsigned char*)d_ws;
    for (int li = 0; li < N_LAUNCHES; ++li) {
        a.ph_lo = (N_LAUNCHES == 1) ? 0 : li; a.ph_hi = (N_LAUNCHES == 1) ? N_PHASES : li + 1; a.li = li;
        hipLaunchKernelGGL(mk_fwd, dim3(grid), dim3(NWAVES * 64), LDS_BYTES, stream, a);
    }
}
```

```cpp
#include <hip/hip_runtime.h>
#include <cstdio>
#include <cstdint>
namespace pg8 {
#define PG8_LAS __attribute__((address_space(3)))
typedef unsigned short bf16_t;
typedef short bf16x8 __attribute__((ext_vector_type(8)));
typedef float f32x4 __attribute__((ext_vector_type(4)));
typedef unsigned u32x4 __attribute__((ext_vector_type(4)));
constexpr int BM = 256, BK = 64, HALF = 128, HTB = HALF * BK * 2  , STAGE_BYTES = 8 * HTB, NXCD = 8, WGM = 8;

__host__ __device__ __forceinline__ int lds_byte(int r, int c) { const int st = (r >> 4) * 2 + (c >> 5), rr = r & 15, cc = c & 31, ob = rr * 64 + cc * 2; return st * 1024 + (ob ^ (((ob >> 9) & 1) << 5)); }
__host__ __device__ __forceinline__ void stage_rc(int b, int& R, int& C) { const int st = b / 1024, sb = b % 1024, swz = sb ^ (((sb >> 9) & 1) << 5); R = (st >> 1) * 16 + swz / 64; C = (st & 1) * 32 + (swz % 64) / 2; }
__host__ __device__ __forceinline__ int perm32(int rho) { const int n = rho >> 4, i = rho & 15; return 8 * (i >> 2) + 4 * n + (i & 3); }

struct Unit { int pm, pn; };
struct Gemm { const bf16_t* A; const bf16_t* Bt; int M, N, K; };

struct StaticOrder {
    int nM, nN, nwg, G, c;
    __host__ __device__ __forceinline__ void init(int M, int N, int G_, int c_) { nM = M / BM; nN = N / BM; nwg = nM * nN; G = G_; c = c_; }
    __host__ __device__ __forceinline__ bool next(int i, Unit& u) const {
        const long L = (long)i * G + c; if (L >= nwg) return false;
        int wgid = (int)L; { const int q = nwg / NXCD, r = nwg % NXCD, xcd = wgid % NXCD, off = wgid / NXCD; wgid = (xcd < r ? xcd * (q + 1) : r * (q + 1) + (xcd - r) * q) + off; }
        const int nig = WGM * nN, gid = wgid / nig, fm = gid * WGM, gsz = (nM - fm) < WGM ? (nM - fm) : WGM;
        u.pm = fm + ((wgid % nig) % gsz); u.pn = (wgid % nig) / gsz; return true;
    }
    __device__ __forceinline__ void a_ready(const Unit&) const {}
    __device__ __forceinline__ void done(const Unit&) const {}
};
__device__ __forceinline__ unsigned cvt_pk_bf16(float lo, float hi) { unsigned r; asm volatile("v_cvt_pk_bf16_f32 %0, %1, %2" : "=v"(r) : "v"(lo), "v"(hi)); return r; }
template <class Epi, class Sched, bool ALIGN_EPI = false, bool SP2 = false>
__device__ __forceinline__ void gemm_phase(PG8_LAS unsigned char* lds, const Gemm g, const Sched& S, const Epi& E) {
    int tid_ = threadIdx.x; asm volatile("" : "+v"(tid_)); const int tid = tid_, wid = __builtin_amdgcn_readfirstlane(tid >> 6), lane = tid & 63, wr = wid >> 2, wc = wid & 3, fr = lane & 15, fq = lane >> 4;
    const int K = g.K, nt = K / BK;
    unsigned voffA[2], voffB[2];
#pragma unroll
    for (int i = 0; i < 2; ++i) { int R, C; stage_rc(tid * 16 + i * 8192, R, C); const int Rb = Epi::PERM ? ((R & ~31) + perm32(R & 31)) : R;
        voffA[i] = (unsigned)(R * K + C) * 2u; voffB[i] = (unsigned)(Rb * K + C) * 2u; }
    const size_t kstep = (size_t)(BK * 2);
    const size_t hstep = (size_t)HALF * K * 2;
    const size_t tstep = 2 * hstep;
    const unsigned ldsw = (unsigned)wid * 1024u;
    const int aoff = lds_byte(wr * 64 + fr, fq * 8), boff = lds_byte(wc * 32 + fr, fq * 8);
#define PG8_SA(b, h) (((b) * 2 + (h)) * HTB)
#define PG8_SB(b, h) ((4 + (b) * 2 + (h)) * HTB)
#define PG8_STAGE(bufoff, gbase, voff) do { _Pragma("unroll") for (int _i = 0; _i < 2; ++_i) \
        __builtin_amdgcn_global_load_lds((const unsigned*)((const char*)(gbase) + (voff)[_i]), (PG8_LAS unsigned*)(lds + (bufoff) + ldsw + _i * 8192), 16, 0, 0); } while (0)
#define PG8_LDA(dst, b, h) do { _Pragma("unroll") for (int m = 0; m < 4; ++m) _Pragma("unroll") for (int k = 0; k < 2; ++k) dst[m][k] = *(const PG8_LAS bf16x8*)(lds + PG8_SA(b, h) + aoff + m * 2048 + k * 1024); } while (0)
#define PG8_LDB(dst, b, h) do { _Pragma("unroll") for (int n = 0; n < 2; ++n) _Pragma("unroll") for (int k = 0; k < 2; ++k) dst[n][k] = *(const PG8_LAS bf16x8*)(lds + PG8_SB(b, h) + boff + n * 2048 + k * 1024); } while (0)
#define PG8_MMA(ai, bj, At, Bt) do { __builtin_amdgcn_s_setprio(1); _Pragma("unroll") for (int m = 0; m < 4; ++m) _Pragma("unroll") for (int n = 0; n < 2; ++n) _Pragma("unroll") for (int k = 0; k < 2; ++k) \
        acc[ai][bj][m][n] = __builtin_amdgcn_mfma_f32_16x16x32_bf16(Bt[n][k], At[m][k], acc[ai][bj][m][n], 0, 0, 0); __builtin_amdgcn_s_setprio(0); } while (0)
#define PG8_WAIT_V(n) asm volatile("s_waitcnt vmcnt(" #n ")" ::: "memory")
#define PG8_WAIT_L(n) asm volatile("s_waitcnt lgkmcnt(" #n ")" ::: "memory")
#define PG8_BAR __builtin_amdgcn_s_barrier()
#define PG8_SCHED __builtin_amdgcn_sched_barrier(0)
    Unit cur, nxt; int ui = 0;
    if (!S.next(0, cur)) return;
    f32x4 acc[2][2][4][2];
#pragma unroll
    for (int a = 0; a < 2; ++a)
#pragma unroll
        for (int b = 0; b < 2; ++b)
#pragma unroll
            for (int m = 0; m < 4; ++m)
#pragma unroll
                for (int n = 0; n < 2; ++n) acc[a][b][m][n] = (f32x4){0.f, 0.f, 0.f, 0.f};
    bf16x8 At[4][2], B0[2][2], B1[2][2];
    const char* cA = (const char*)g.A + (size_t)cur.pm * tstep; const char* cB = (const char*)g.Bt + (size_t)cur.pn * tstep;
    S.a_ready(cur);
    if constexpr (SP2) {
        PG8_STAGE(PG8_SB(0, 0), cB, voffB); PG8_STAGE(PG8_SB(0, 1), cB + hstep, voffB); PG8_STAGE(PG8_SA(0, 0), cA, voffA); PG8_STAGE(PG8_SA(0, 1), cA + hstep, voffA);
        if (wr == 1) PG8_BAR;
        PG8_WAIT_V(2); PG8_BAR;
        PG8_STAGE(PG8_SB(1, 0), cB + kstep, voffB); PG8_STAGE(PG8_SA(1, 0), cA + kstep, voffA); PG8_STAGE(PG8_SB(1, 1), cB + hstep + kstep, voffB);
        PG8_WAIT_V(6); PG8_BAR;
    } else {
        PG8_STAGE(PG8_SB(0, 0), cB, voffB); PG8_STAGE(PG8_SA(0, 0), cA, voffA); PG8_STAGE(PG8_SB(0, 1), cB + hstep, voffB); PG8_STAGE(PG8_SA(0, 1), cA + hstep, voffA);
        if (wr == 1) PG8_BAR;
        PG8_WAIT_V(4); PG8_BAR;
        PG8_STAGE(PG8_SB(1, 0), cB + kstep, voffB); PG8_STAGE(PG8_SA(1, 0), cA + kstep, voffA); PG8_STAGE(PG8_SB(1, 1), cB + hstep + kstep, voffB);
        PG8_WAIT_V(6); PG8_BAR;
    }
    for (;;) {
        const bool has_next = S.next(ui + 1, nxt);
        const char* nA = has_next ? (const char*)g.A + (size_t)nxt.pm * tstep : cA; const char* nB = has_next ? (const char*)g.Bt + (size_t)nxt.pn * tstep : cB;
        for (int t = 0; t < nt; t += 2) {
            const bool last = (t == nt - 2);
            const char* a1 = cA + (size_t)(t + 1) * kstep;
            const char* a2 = last ? nA : cA + (size_t)(t + 2) * kstep; const char* b2 = last ? nB : cB + (size_t)(t + 2) * kstep;
            const char* a3 = a2 + kstep; const char* b3 = b2 + kstep;
            if (last && has_next) S.a_ready(nxt);
            if constexpr (SP2) {
            PG8_LDB(B0, 0, 0); PG8_LDB(B1, 0, 1); PG8_SCHED; PG8_LDA(At, 0, 0); PG8_STAGE(PG8_SA(1, 1), a1 + hstep, voffA);
            PG8_WAIT_V(8); PG8_WAIT_L(0); PG8_BAR; PG8_MMA(0, 0, At, B0); PG8_MMA(0, 1, At, B1); PG8_BAR; PG8_SCHED;
            PG8_LDA(At, 0, 1); PG8_STAGE(PG8_SB(0, 0), b2, voffB); PG8_STAGE(PG8_SB(0, 1), b2 + hstep, voffB); PG8_STAGE(PG8_SA(0, 0), a2, voffA);
            PG8_WAIT_V(8); PG8_WAIT_L(0); PG8_BAR; PG8_MMA(1, 0, At, B0); PG8_MMA(1, 1, At, B1); PG8_BAR; PG8_SCHED;
            PG8_LDB(B0, 1, 0); PG8_LDB(B1, 1, 1); PG8_SCHED; PG8_LDA(At, 1, 0); PG8_STAGE(PG8_SA(0, 1), a2 + hstep, voffA);
            PG8_WAIT_V(8); PG8_WAIT_L(0); PG8_BAR; PG8_MMA(0, 0, At, B0); PG8_MMA(0, 1, At, B1); PG8_BAR; PG8_SCHED;
            PG8_LDA(At, 1, 1); PG8_STAGE(PG8_SB(1, 0), b3, voffB); PG8_STAGE(PG8_SB(1, 1), b3 + hstep, voffB); PG8_STAGE(PG8_SA(1, 0), a3, voffA);
            PG8_WAIT_V(8); PG8_WAIT_L(0); PG8_BAR; PG8_MMA(1, 0, At, B0); PG8_MMA(1, 1, At, B1); PG8_BAR; PG8_SCHED;
            } else {
            PG8_LDB(B0, 0, 0); PG8_SCHED; PG8_LDA(At, 0, 0); PG8_STAGE(PG8_SA(1, 1), a1 + hstep, voffA);
            PG8_WAIT_L(8); PG8_BAR; PG8_WAIT_L(0); PG8_MMA(0, 0, At, B0); PG8_BAR; PG8_SCHED;
            PG8_LDB(B1, 0, 1); PG8_STAGE(PG8_SB(0, 0), b2, voffB);
            PG8_BAR; PG8_WAIT_L(0); PG8_MMA(0, 1, At, B1); PG8_BAR;
            PG8_LDA(At, 0, 1); PG8_STAGE(PG8_SA(0, 0), a2, voffA);
            PG8_BAR; PG8_WAIT_L(0); PG8_MMA(1, 0, At, B0); PG8_BAR; PG8_SCHED;
            PG8_STAGE(PG8_SB(0, 1), b2 + hstep, voffB);
            PG8_WAIT_V(6); PG8_BAR; PG8_MMA(1, 1, At, B1); PG8_BAR;
            PG8_LDB(B0, 1, 0); PG8_SCHED; PG8_LDA(At, 1, 0); PG8_STAGE(PG8_SA(0, 1), a2 + hstep, voffA);
            PG8_WAIT_L(8); PG8_BAR; PG8_WAIT_L(0); PG8_MMA(0, 0, At, B0); PG8_BAR; PG8_SCHED;
            PG8_LDB(B1, 1, 1); PG8_STAGE(PG8_SB(1, 0), b3, voffB);
            PG8_BAR; PG8_WAIT_L(0); PG8_MMA(0, 1, At, B1); PG8_BAR;
            PG8_LDA(At, 1, 1); PG8_STAGE(PG8_SA(1, 0), a3, voffA);
            PG8_BAR; PG8_WAIT_L(0); PG8_MMA(1, 0, At, B0); PG8_BAR; PG8_SCHED;
            PG8_STAGE(PG8_SB(1, 1), b3 + hstep, voffB);
            PG8_WAIT_V(6); PG8_BAR; PG8_MMA(1, 1, At, B1); PG8_BAR;
            }
        }
        if constexpr (ALIGN_EPI) { if (wr == 0) PG8_BAR; }
        if constexpr (!Epi::AFTER_DRAIN) { E(acc, cur, wr, wc, fr, fq); S.done(cur); }
        if (!has_next) break;
#pragma unroll
        for (int a = 0; a < 2; ++a)
#pragma unroll
            for (int b = 0; b < 2; ++b)
#pragma unroll
                for (int m = 0; m < 4; ++m)
#pragma unroll
                    for (int n = 0; n < 2; ++n) acc[a][b][m][n] = (f32x4){0.f, 0.f, 0.f, 0.f};
        cur = nxt; cA = nA; cB = nB; ++ui;
        if constexpr (ALIGN_EPI) { if (wr == 1) PG8_BAR; }
    }
    PG8_WAIT_V(0);
    if constexpr (!ALIGN_EPI) { if (wr == 0) PG8_BAR; }
    PG8_BAR;
    if constexpr (Epi::AFTER_DRAIN) { E.fused(acc, cur, wr, wc, fr, fq, lds, wid, lane); S.done(cur); }
#undef PG8_SA
#undef PG8_SB
#undef PG8_STAGE
#undef PG8_LDA
#undef PG8_LDB
#undef PG8_MMA
#undef PG8_WAIT_V
#undef PG8_WAIT_L
#undef PG8_BAR
#undef PG8_SCHED
}
}

#ifndef MK_N_LAUNCHES
#define MK_N_LAUNCHES 1
#endif
constexpr int N_PHASES = 12;
#ifndef DUP_MASK
#define DUP_MASK 0
#endif
#define NREP(k) ((((DUP_MASK) >> (k)) & 1) ? 2 : 1)
constexpr int N_LAUNCHES = MK_N_LAUNCHES;
constexpr int NWAVES = 8;
constexpr int DM = 1024, NBATCH = 8, SEQ = 2048, TP = NBATCH * SEQ, NS = 128, TT = TP + NS;
constexpr int NPROJ = 3072;
constexpr int NIN = 3088;
constexpr int CH = 64, NCH = SEQ / CH, NBC = NBATCH * NCH;
constexpr float EPS = 1e-6f;
constexpr int POS_S = 16384;
constexpr int C_S5U = 0, C_S5Z = 256, C_HGQ = 512, C_HGF = 768, C_HGI = 1024, C_HGZ = 1280, C_GLQ = 1536, C_GLK = 1664, C_GLV = 1792, C_GLZ = 2048, C_RTQ = 2304, C_RTK = 2432, C_RTV = 2560, C_RTZ = 2816;
enum { I_XP = 0, I_XS, I_S5RE, I_S5IM, I_SHG, I_SGLA, I_SRET, I_NORMW, I_FNORMW, I_WIN, I_WOUT, I_LAMRE, I_LAMIM, I_LOGSTEP, I_BRE, I_BIM, I_CRE, I_CIM, I_S5D, I_WGLU, I_LBLOG, I_HGNW, I_GLWUP, I_GLB, I_GLNW, I_RTNW, N_INPUTS };
constexpr size_t O_YP = 0, O_YS = O_YP + (size_t)TP * DM, O_S5RE_P = O_YS + (size_t)NS * DM, O_S5IM_P = O_S5RE_P + 2 * 8 * 1024, O_HG_P = O_S5IM_P + 2 * 8 * 1024,
    O_GLA_P = O_HG_P + 2 * 8 * 16384, O_RET_P = O_GLA_P + 2 * 8 * 8192, O_S5RE_S = O_RET_P + 2 * 8 * 8192, O_S5IM_S = O_S5RE_S + 2 * 128 * 1024, O_HG_S = O_S5IM_S + 2 * 128 * 1024,
    O_GLA_S = O_HG_S + (size_t)2 * 128 * 16384, O_RET_S = O_GLA_S + (size_t)2 * 128 * 8192, O_END = O_RET_S + (size_t)2 * 128 * 8192;

constexpr size_t MiB = 1u << 20;
constexpr size_t WS_CTL = 0, CTL_ZERO_BYTES = 64 * 1024;
constexpr size_t WS_WIN = 2 * MiB;
constexpr size_t WS_WOUT = 14 * MiB;
constexpr size_t WS_WLR = 18 * MiB;
constexpr size_t WS_WGLU = WS_WLR + 64 * 1024;
constexpr size_t WS_BBT = WS_WGLU + 256 * 1024;
constexpr size_t WS_CCN = WS_BBT + 128 * 1024;
constexpr size_t WS_S5A = WS_CCN + 128 * 1024;
constexpr size_t WS_LB = WS_S5A + 32 * 1024;
constexpr size_t WS_ROT = WS_LB + 4 * 1024;
constexpr size_t WS_XB = 20 * MiB;
constexpr size_t WS_ROWSS = 53 * MiB;
constexpr size_t WS_ROWSS_S = WS_ROWSS + (size_t)TP * 16 * 4;
constexpr size_t WS_GG = 224 * MiB;
constexpr size_t WS_PROJ = 57 * MiB;
constexpr size_t WS_MIX = 154 * MiB;
constexpr size_t WS_SLOC = 187 * MiB;
constexpr size_t WS_DEC = 219 * MiB;
constexpr size_t WS_S5LOC = 220 * MiB;
constexpr size_t WS_END = 233 * MiB;
static_assert(WS_ROT + 2 * 2048 * 16 * 4 + 256 <= WS_XB && WS_XB + (size_t)TT * DM * 2 <= WS_ROWSS && WS_ROWSS_S + 128 * 32 * 4 <= WS_PROJ, "ws map");
static_assert(WS_PROJ + (size_t)TT * NPROJ * 2 <= WS_MIX && WS_MIX + (size_t)TT * DM * 2 <= WS_SLOC && WS_SLOC + (size_t)NBC * 32768 * 4 <= WS_DEC && WS_DEC + (size_t)NBC * 512 * 4 <= WS_S5LOC && WS_S5LOC + (size_t)NBC * 2048 * 4 <= WS_GG && WS_GG + (size_t)TT * 128 * 4 <= WS_END, "ws map");
constexpr int CW_BAR = 4096;

constexpr int RING_BYTES = 131072;
constexpr int LDSCTL_OFF = RING_BYTES, MISC_OFF = LDSCTL_OFF + 320;
constexpr int LDS_BYTES = 147456;

#define LAS __attribute__((address_space(3)))
typedef unsigned short bf16;
typedef short bf16x8 __attribute__((ext_vector_type(8)));
typedef short bf16x4 __attribute__((ext_vector_type(4)));
typedef float f32x4 __attribute__((ext_vector_type(4)));
typedef float f32x2 __attribute__((ext_vector_type(2)));
typedef float f32x16 __attribute__((ext_vector_type(16)));
typedef unsigned u32x4 __attribute__((ext_vector_type(4)));
typedef unsigned u32x2 __attribute__((ext_vector_type(2)));
#define RLX_AGENT __ATOMIC_RELAXED, __HIP_MEMORY_SCOPE_AGENT
#define LDS_WAIT() asm volatile("s_waitcnt lgkmcnt(0)" ::: "memory")
#define VM_WAIT() asm volatile("s_waitcnt vmcnt(0)" ::: "memory")

__device__ __forceinline__ void bsync() { __builtin_amdgcn_fence(__ATOMIC_RELEASE, "workgroup"); __builtin_amdgcn_s_barrier(); __builtin_amdgcn_fence(__ATOMIC_ACQUIRE, "workgroup"); }
__device__ __forceinline__ unsigned f2bf(float f) { unsigned u = __builtin_bit_cast(unsigned, f); return (u + 0x7fffu + ((u >> 16) & 1u)) >> 16; }
__device__ __forceinline__ unsigned pk2(float lo, float hi) { return f2bf(lo) | (f2bf(hi) << 16); }
__device__ __forceinline__ float bf2f(short b) { return __builtin_bit_cast(float, ((unsigned)(unsigned short)b) << 16); }
__device__ __forceinline__ u32x4 pack8(const float* v) { u32x4 w; w.x = pk2(v[0], v[1]); w.y = pk2(v[2], v[3]); w.z = pk2(v[4], v[5]); w.w = pk2(v[6], v[7]); return w; }
__device__ __forceinline__ float rcpf_(float x) { return __builtin_amdgcn_rcpf(x); }
__device__ __forceinline__ float sigmoidf_(float x) { return rcpf_(1.0f + __expf(-x)); }
__device__ __forceinline__ float siluf_(float x) { return x * rcpf_(1.0f + __expf(-x)); }
__device__ __forceinline__ float logsigmoidf_(float x) { return fminf(x, 0.f) - __logf(1.0f + __expf(-fabsf(x))); }
__device__ __forceinline__ float gelu_tanh(float x) { const float u = 0.7978845608028654f * (x + 0.044715f * x * x * x); return x * rcpf_(1.0f + __expf(-2.0f * u)); }
__device__ __forceinline__ float wave_sum(float v) {
#pragma unroll
    for (int o = 1; o < 64; o <<= 1) v += __shfl_xor(v, o);
    return v;
}

#define XB_TMO      128
#define XB_XCNT(j)  (256  + 64 * (j))
#define XB_XSUB(j)  (1280 + 64 * (j))
#define XB_XGEN(j)  (2304 + 64 * (j))
#define XB_TOP      3328
#define XB_TOPGEN   3392
#define XCD_BAR_WORDS 3456
#define XB_SPIN_CAP (1u << 18)
__device__ __forceinline__ unsigned xb_ld(unsigned* p)              { return __hip_atomic_load(p, __ATOMIC_RELAXED, __HIP_MEMORY_SCOPE_AGENT); }
__device__ __forceinline__ unsigned xb_add(unsigned* p, unsigned v) { return __hip_atomic_fetch_add(p, v, __ATOMIC_RELAXED, __HIP_MEMORY_SCOPE_AGENT); }
__device__ __forceinline__ unsigned xb_xcc_id() { return (unsigned)__builtin_amdgcn_s_getreg((3 << 11) | 20) & 0xFu; }
#define XB_SPIN(cond, bar) do { unsigned _sp = 0; while (cond) { __builtin_amdgcn_s_sleep(1); \
    if ((++_sp & 255u) == 0u) { if (xb_ld(&(bar)[XB_TMO])) break; if (_sp > XB_SPIN_CAP) { atomicAdd(&(bar)[XB_TMO], 1u); break; } } } } while (0)
struct XcdBarrier { unsigned* bar; unsigned x; volatile LAS unsigned* st; };
__device__ __forceinline__ XcdBarrier xcd_barrier_post(unsigned* bar, volatile LAS unsigned* st) {
    XcdBarrier b; b.bar = bar; b.x = xb_xcc_id(); b.st = st;
    if (threadIdx.x == 0) (void)xb_add(&bar[XB_XCNT(b.x)], 1u);
    return b;
}
__device__ __forceinline__ void xcd_barrier_complete(unsigned* bar, unsigned x, unsigned& nloc, unsigned& nx) {
    const unsigned G = gridDim.x * gridDim.y * gridDim.z;
    unsigned sum, cnt, mine, sp = 0u;
    for (;;) {
        sum = 0u; cnt = 0u; mine = 0u;
#pragma unroll
        for (unsigned j = 0; j < 16; ++j) { const unsigned c = xb_ld(&bar[XB_XCNT(j)]); sum += c; cnt += (c > 0u) ? 1u : 0u; mine = (j == x) ? c : mine; }
        if (sum == G) break;
        __builtin_amdgcn_s_sleep(1);
        if ((++sp & 255u) == 0u) { if (xb_ld(&bar[XB_TMO])) break; if (sp > XB_SPIN_CAP) { atomicAdd(&bar[XB_TMO], 1u); break; } }
    }
    nloc = mine > 0u ? mine : 1u; nx = cnt > 0u ? cnt : 1u;
}
__device__ __forceinline__ void xcd_barrier(const XcdBarrier& b) {
    asm volatile("s_waitcnt vmcnt(0)" ::: "memory");
    bsync();
    if (threadIdx.x == 0) {
        unsigned* bar = b.bar;
        __builtin_amdgcn_s_waitcnt(0);
        unsigned nloc = b.st[0], nx = b.st[1];
        if (nloc == 0u) { xcd_barrier_complete(bar, b.x, nloc, nx); b.st[0] = nloc; b.st[1] = nx; }
        const unsigned old = xb_add(&bar[XB_XSUB(b.x)], 1u);
        const unsigned gen = old / nloc;
        if (old + 1u == (gen + 1u) * nloc) {
            __builtin_amdgcn_fence(__ATOMIC_RELEASE, "agent");
            asm volatile("s_waitcnt vmcnt(0)" ::: "memory");
            const unsigned og = xb_add(&bar[XB_TOP], 1u);
            const unsigned tg = og / nx;
            if (og + 1u == (tg + 1u) * nx) xb_add(&bar[XB_TOPGEN], 1u);
            else XB_SPIN(xb_ld(&bar[XB_TOPGEN]) == tg, bar);
            __builtin_amdgcn_fence(__ATOMIC_ACQUIRE, "agent");
            xb_add(&bar[XB_XGEN(b.x)], 1u);
            asm volatile("s_waitcnt vmcnt(0)" ::: "memory");
        } else {
            XB_SPIN(xb_ld(&bar[XB_XGEN(b.x)]) == gen, bar);
            __builtin_amdgcn_fence(__ATOMIC_ACQUIRE, "agent");
            asm volatile("s_waitcnt vmcnt(0)" ::: "memory");
        }
    }
    bsync();
}

struct Args { const float* in[N_INPUTS]; float* out; unsigned char* ws; int ph_lo, ph_hi, li, pad; };
#define KARG (F.kp)
#define INP(i) ((const float*)KARG->in[i])
#define OUTP ((float*)KARG->out)
#define WSP ((unsigned char*)KARG->ws)
#define P_WIN ((bf16*)(WSP + WS_WIN))
#define P_WOUT ((bf16*)(WSP + WS_WOUT))
#define P_WLR ((bf16*)(WSP + WS_WLR))
#define P_WGLU ((bf16*)(WSP + WS_WGLU))
#define P_BBT ((bf16*)(WSP + WS_BBT))
#define P_CCN ((bf16*)(WSP + WS_CCN))
#define P_XB ((bf16*)(WSP + WS_XB))
#define P_PROJ ((bf16*)(WSP + WS_PROJ))
#define P_MIX ((bf16*)(WSP + WS_MIX))
#define P_S5A ((float*)(WSP + WS_S5A))
#define P_LB ((float*)(WSP + WS_LB))
#define P_ROT ((float*)(WSP + WS_ROT))
#define P_ROWSS ((float*)(WSP + WS_ROWSS))
#define P_ROWSS_S ((float*)(WSP + WS_ROWSS_S))
#define P_GG ((float*)(WSP + WS_GG))
#define P_SLOC ((float*)(WSP + WS_SLOC))
#define P_DEC ((float*)(WSP + WS_DEC))
#define P_S5LOC ((float*)(WSP + WS_S5LOC))
typedef const __attribute__((address_space(4))) Args* KargPtr;
struct Frame { LAS unsigned char* lds; int tid, lane, wave, G, bid; KargPtr kp; };
__device__ __forceinline__ Frame fresh(const Frame& F0) {
    Frame R; R.lds = F0.lds; int t = F0.tid; asm volatile("" : "+v"(t)); R.tid = t; R.lane = t & 63; R.wave = __builtin_amdgcn_readfirstlane(t >> 6);
    int g = F0.G, b = F0.bid; asm volatile("" : "+s"(g), "+s"(b)); R.G = g; R.bid = b;
    KargPtr p = F0.kp; asm volatile("" : "+s"(p)); R.kp = p; return R;
}

namespace pg8 {
struct EpiProj {
    static constexpr bool PERM = true, AFTER_DRAIN = false;
    bf16_t* O; const float* rowss;
    __device__ __forceinline__ void operator()(const f32x4 (&acc)[2][2][4][2], const Unit& u, int wr, int wc, int fr, int fq) const {
        const int row0 = u.pm * BM + wr * 64 + fr, col0 = u.pn * BM + wc * 32 + 8 * fq;
#pragma unroll
        for (int ai = 0; ai < 2; ++ai)
#pragma unroll
            for (int m = 0; m < 4; ++m) {
                const int row = row0 + ai * HALF + m * 16;
                const f32x4* rp = (const f32x4*)(rowss + (size_t)row * 16);
                const f32x4 p0 = rp[0], p1 = rp[1], p2 = rp[2], p3 = rp[3];
                const float ss = ((p0[0] + p0[1]) + (p0[2] + p0[3])) + ((p1[0] + p1[1]) + (p1[2] + p1[3])) + ((p2[0] + p2[1]) + (p2[2] + p2[3])) + ((p3[0] + p3[1]) + (p3[2] + p3[3]));
                const float rstd = 1.0f / sqrtf(ss * (1.0f / 1024.0f) + 1e-6f);
                bf16_t* rowp = O + (size_t)row * 3072 + col0;
#pragma unroll
                for (int bj = 0; bj < 2; ++bj) { const f32x4 v0 = acc[ai][bj][m][0] * rstd, v1 = acc[ai][bj][m][1] * rstd;
                    u32x4 w; w.x = cvt_pk_bf16(v0[0], v0[1]); w.y = cvt_pk_bf16(v0[2], v0[3]); w.z = cvt_pk_bf16(v1[0], v1[1]); w.w = cvt_pk_bf16(v1[2], v1[3]);
                    *(u32x4*)(rowp + bj * HALF) = w; }
            }
    }
};
struct EpiRes {
    static constexpr bool PERM = false, AFTER_DRAIN = false;
    const float* base; float* xo; bf16_t* xb; float* rowss;
    __device__ __forceinline__ void operator()(const f32x4 (&acc)[2][2][4][2], const Unit& u, int wr, int wc, int fr, int fq) const {
        const int row0 = u.pm * BM + wr * 64 + fr, col0 = u.pn * BM + wc * 32 + 4 * fq;
#pragma unroll
        for (int ai = 0; ai < 2; ++ai)
#pragma unroll
            for (int m = 0; m < 4; ++m) {
                const int row = row0 + ai * HALF + m * 16; const size_t off = (size_t)row * 1024 + col0; float ss = 0.f;
#pragma unroll
                for (int bj = 0; bj < 2; ++bj)
#pragma unroll
                    for (int n = 0; n < 2; ++n) { const f32x4 bs = *(const f32x4*)(base + off + bj * HALF + n * 16); const f32x4 o = bs + acc[ai][bj][m][n];
                        *(f32x4*)(xo + off + bj * HALF + n * 16) = o; ss += (o[0] * o[0] + o[1] * o[1]) + (o[2] * o[2] + o[3] * o[3]);
                        if (xb) { typedef unsigned u32x2v __attribute__((ext_vector_type(2))); u32x2v w; w.x = cvt_pk_bf16(o[0], o[1]); w.y = cvt_pk_bf16(o[2], o[3]); *(u32x2v*)(xb + off + bj * HALF + n * 16) = w; } }
                ss += __shfl_xor(ss, 16); ss += __shfl_xor(ss, 32);
                if (fq == 0) rowss[(size_t)row * 16 + u.pn * 4 + wc] = ss;
                asm volatile("" ::: "memory");
            }
    }
};
}

__device__ __forceinline__ f32x4 tile16(const LAS bf16* A, int lda, const LAS bf16* Bt, int ldb, int K, int lane) {
    const LAS bf16* ap = A + (lane & 15) * lda + 8 * (lane >> 4);
    const LAS bf16* bp = Bt + (lane & 15) * ldb + 8 * (lane >> 4);
    f32x4 acc = {0.f, 0.f, 0.f, 0.f};
    for (int k0 = 0; k0 < K; k0 += 32) {
        const bf16x8 a = *(const LAS bf16x8*)(ap + k0), b = *(const LAS bf16x8*)(bp + k0);
        acc = __builtin_amdgcn_mfma_f32_16x16x32_bf16(a, b, acc, 0, 0, 0);
    }
    return acc;
}

template <int NT>
__device__ __forceinline__ void small_unit(const bf16* A, const bf16* Bt, int wave, int lane, f32x4 (&acc)[NT]) {
    const bf16* ap = A + (size_t)(16 * wave + (lane & 15)) * 1024 + 8 * (lane >> 4);
    const bf16* bp = Bt + (size_t)(lane & 15) * 1024 + 8 * (lane >> 4);
#pragma unroll
    for (int n = 0; n < NT; ++n) acc[n] = (f32x4){0.f, 0.f, 0.f, 0.f};
#pragma unroll 8
    for (int ks = 0; ks < 32; ++ks) {
        const bf16x8 a = *(const bf16x8*)(ap + 32 * ks);
#pragma unroll
        for (int n = 0; n < NT; ++n) { const bf16x8 b = *(const bf16x8*)(bp + (size_t)n * 16 * 1024 + 32 * ks); acc[n] = __builtin_amdgcn_mfma_f32_16x16x32_bf16(b, a, acc[n], 0, 0, 0); }
    }
}

__device__ __forceinline__ void p0_transpose_item(const float* W, int ldw, int k0, int nsrc0, const float* ks, bf16* WT, int ldt, int ndst0, int nkeep, LAS float* scr, int lane) {
#pragma unroll 8
    for (int i = 0; i < 32; ++i) { const int kk = 2 * i + (lane >> 5); float v = W[(size_t)(k0 + kk) * ldw + nsrc0 + (lane & 31)]; if (ks) v *= ks[k0 + kk]; scr[kk * 33 + (lane & 31)] = v; }
    LDS_WAIT();
    const int c = lane & 7;
#pragma unroll
    for (int j = 0; j < 4; ++j) { const int n = (lane >> 3) + 8 * j; const LAS float* s = scr + (8 * c) * 33 + n;
        u32x4 o; o.x = pk2(s[0 * 33], s[1 * 33]); o.y = pk2(s[2 * 33], s[3 * 33]); o.z = pk2(s[4 * 33], s[5 * 33]); o.w = pk2(s[6 * 33], s[7 * 33]);
        if (n < nkeep) *(u32x4*)(WT + (size_t)(ndst0 + n) * ldt + k0 + 8 * c) = o; }
    LDS_WAIT();
}

__device__ __forceinline__ void p0_prologue(const Frame& F0, int parts) {
    const Frame F = fresh(F0);
    LAS float* scr = (LAS float*)(F.lds + F.wave * 16384);
    const int gw = F.bid * NWAVES + F.wave, NGW = F.G * NWAVES, lane = F.lane;
    constexpr int I_IN = 16 * 96, I_LRI = 16, I_OUT = 16 * 32, I_GLU = 4 * 8, PER_L = I_IN + I_LRI + I_OUT + I_GLU;
    if (parts & 1)
    for (int it = gw; it < 2 * PER_L; it += NGW) {
        const int l = it / PER_L; int r = it % PER_L;
        const float* win = INP(I_WIN) + (size_t)l * 1024 * NIN; const float* nw = INP(I_NORMW) + l * 1024;
        if (r < I_IN) { const int kb = r / 96, nb = r % 96, n0 = 32 * nb, ns = n0 < 2048 ? n0 : n0 + 16;
            p0_transpose_item(win, NIN, 64 * kb, ns, nw, P_WIN + (size_t)l * NPROJ * 1024, 1024, n0, 32, scr, lane); continue; } r -= I_IN;
        if (r < I_LRI) { p0_transpose_item(win, NIN, 64 * r, 2048, nw, P_WLR + (size_t)l * 16 * 1024, 1024, 0, 16, scr, lane); continue; } r -= I_LRI;
        if (r < I_OUT) { const int kb = r / 32, nb = r % 32;
            p0_transpose_item(INP(I_WOUT) + (size_t)l * 1024 * 1024, 1024, 64 * kb, 32 * nb, nullptr, P_WOUT + (size_t)l * 1024 * 1024, 1024, 32 * nb, 32, scr, lane); continue; } r -= I_OUT;
        { const int kb = r / 8, nb = r % 8;
            p0_transpose_item(INP(I_WGLU) + (size_t)l * 256 * 256, 256, 64 * kb, 32 * nb, nullptr, P_WGLU + (size_t)l * 256 * 256, 256, 32 * nb, 32, scr, lane); }
    }
    if (parts & 2)
    for (int m = gw; m < TT; m += NGW) {
        const float* xrow = m < TP ? INP(I_XP) + (size_t)m * DM : INP(I_XS) + (size_t)(m - TP) * DM;
        const f32x4* xr = (const f32x4*)xrow + lane;
        f32x4 v[4]; float s = 0.f;
#pragma unroll
        for (int j = 0; j < 4; ++j) { v[j] = xr[64 * j]; s += (v[j][0] * v[j][0] + v[j][1] * v[j][1]) + (v[j][2] * v[j][2] + v[j][3] * v[j][3]); }
        s = wave_sum(s);
        u32x2* o8 = (u32x2*)(P_XB + (size_t)m * DM) + lane;
#pragma unroll
        for (int j = 0; j < 4; ++j) { u32x2 w; w.x = pk2(v[j][0], v[j][1]); w.y = pk2(v[j][2], v[j][3]); o8[64 * j] = w; }
        if (m < TP) { if (lane < 16) P_ROWSS[(size_t)m * 16 + lane] = lane == 0 ? s : 0.f; }
        else { if (lane < 32) P_ROWSS_S[(size_t)(m - TP) * 32 + lane] = lane == 0 ? s : 0.f; }
    }
    const int gt = F.bid * 512 + F.tid, NGT = F.G * 512;
    if (parts & 4)
    for (int i = gt; i < 2 * 16 * 64; i += NGT) {
        const int l = i >> 10, g = (i >> 6) & 15, p = i & 63;
        const float lr = INP(I_LAMRE)[i], li = INP(I_LAMIM)[i], step = expf(INP(I_LOGSTEP)[l * 16 + g]);
        const float mag = expf(lr * step), are = mag * cosf(li * step), aim = mag * sinf(li * step);
        const float den = lr * lr + li * li, nr = are - 1.0f;
        const float fre = (nr * lr + aim * li) / den, fim = (aim * lr - nr * li) / den;
        const float m64 = expf(lr * step * 64.f), a64r = m64 * cosf(li * step * 64.f), a64i = m64 * sinf(li * step * 64.f);
        float* sa = P_S5A + (size_t)i * 4; sa[0] = are; sa[1] = aim; sa[2] = a64r; sa[3] = a64i;
        const float* bre = INP(I_BRE) + (size_t)i * 16; const float* bim = INP(I_BIM) + (size_t)i * 16;
        bf16* bb = P_BBT + (size_t)(l * 16 + g) * 128 * 16;
        for (int c = 0; c < 16; ++c) { const float br = bre[c], bi = bim[c];
            bb[(p) * 16 + c] = (bf16)f2bf(fre * br - fim * bi); bb[(64 + p) * 16 + c] = (bf16)f2bf(fre * bi + fim * br); }
        const float* cre = INP(I_CRE) + (size_t)(l * 16 + g) * 16 * 64; const float* cim = INP(I_CIM) + (size_t)(l * 16 + g) * 16 * 64;
        bf16* cc = P_CCN + (size_t)(l * 16 + g) * 16 * 128;
        for (int c = 0; c < 16; ++c) { cc[c * 128 + p] = (bf16)f2bf(cre[c * 64 + p]); cc[c * 128 + 64 + p] = (bf16)f2bf(-cim[c * 64 + p]); }
    }
    if (parts & 4)
    for (int i = gt; i < 256; i += NGT) { const float l0 = INP(I_LBLOG)[i], l1 = INP(I_LBLOG)[256 + i]; P_LB[i] = 0.f; P_LB[256 + i] = 1.0f / (1.0f + expf(l0 - l1)); }
    if (parts & 4)
    for (int i = gt; i < 2049 * 16; i += NGT) { const int pos = i >> 4, j = i & 15; const float inv = powf(10000.0f, -(float)j / 16.0f);
        const float ang = (pos < 2048 ? (float)pos : (float)POS_S) * inv; P_ROT[i] = cosf(ang); P_ROT[2049 * 16 + i] = sinf(ang); }
}

__device__ __forceinline__ float rstd_prompt(const Frame& F, int row) {
    const f32x4* rp = (const f32x4*)(P_ROWSS + (size_t)row * 16); const f32x4 p0 = rp[0], p1 = rp[1], p2 = rp[2], p3 = rp[3];
    const float ss = ((p0[0] + p0[1]) + (p0[2] + p0[3])) + ((p1[0] + p1[1]) + (p1[2] + p1[3])) + ((p2[0] + p2[1]) + (p2[2] + p2[3])) + ((p3[0] + p3[1]) + (p3[2] + p3[3]));
    return 1.0f / sqrtf(ss * (1.0f / 1024.0f) + EPS);
}
__device__ __forceinline__ float rstd_sample(const Frame& F, int srow) {
    const f32x4* rp = (const f32x4*)(P_ROWSS_S + (size_t)srow * 32); float ss = 0.f;
#pragma unroll
    for (int i = 0; i < 8; ++i) { const f32x4 p = rp[i]; ss += (p[0] + p[1]) + (p[2] + p[3]); }
    return 1.0f / sqrtf(ss * (1.0f / 1024.0f) + EPS);
}
constexpr int N_G1_SMALL = 129 + 96;
__device__ __forceinline__ void g1_small_unit(const Frame& F0, int l, int u) {
    const Frame F = fresh(F0);
    const int wave = F.wave, lane = F.lane, r = lane & 15, q = lane >> 4;
    if (u <= 128) {
        const int row0 = u * 128;
        f32x4 acc[1];
        small_unit<1>(P_XB + (size_t)row0 * 1024, P_WLR + (size_t)l * 16 * 1024, wave, lane, acc);
        const int row = row0 + 16 * wave + r;
        const float rs = row < TP ? rstd_prompt(F, row) : rstd_sample(F, row - TP);
        float lrv[16];
#pragma unroll
        for (int qq = 0; qq < 4; ++qq)
#pragma unroll
            for (int rr = 0; rr < 4; ++rr) lrv[4 * qq + rr] = __shfl(acc[0][rr] * rs, r + 16 * qq);
        const float* wup = INP(I_GLWUP) + (size_t)l * 16 * 128 + 32 * q; const float* bg = INP(I_GLB) + l * 128 + 32 * q;
        float* gout = P_GG + (size_t)row * 128 + 32 * q;
#pragma unroll 2
        for (int jc = 0; jc < 8; ++jc) { f32x4 a4 = *(const f32x4*)(bg + 4 * jc);
#pragma unroll
            for (int rr = 0; rr < 16; ++rr) a4 += *(const f32x4*)(wup + rr * 128 + 4 * jc) * lrv[rr];
            f32x4 g4;
#pragma unroll
            for (int j = 0; j < 4; ++j) g4[j] = logsigmoidf_(a4[j]) * (1.0f / 16.0f);
            *(f32x4*)(gout + 4 * jc) = g4; }
    } else {
        const int c0 = (u - 129) * 32;
        f32x4 acc[2];
        small_unit<2>(P_XB + (size_t)TP * 1024, P_WIN + (size_t)l * NPROJ * 1024 + (size_t)c0 * 1024, wave, lane, acc);
        const int srow = 16 * wave + r; const float rs = rstd_sample(F, srow);
#pragma unroll
        for (int n = 0; n < 2; ++n) { const f32x4 v = acc[n] * rs; u32x2 w; w.x = pk2(v[0], v[1]); w.y = pk2(v[2], v[3]);
            *(u32x2*)(P_PROJ + (size_t)(TP + srow) * NPROJ + c0 + 16 * n + 4 * q) = w; }
    }
}
__device__ __forceinline__ void g2_small_unit(const Frame& F0, int l, int u) {
    const Frame F = fresh(F0);
    const int wave = F.wave, lane = F.lane, r = lane & 15, q = lane >> 4, c0 = u * 32;
    f32x4 acc[2];
    small_unit<2>(P_MIX + (size_t)TP * 1024, P_WOUT + (size_t)l * 1024 * 1024 + (size_t)c0 * 1024, wave, lane, acc);
    const int srow = 16 * wave + r;
    const float* base = (l == 0 ? INP(I_XS) : OUTP + O_YS) + (size_t)srow * 1024;
    float* xo = OUTP + O_YS + (size_t)srow * 1024; float ss = 0.f;
#pragma unroll
    for (int n = 0; n < 2; ++n) { const int c = c0 + 16 * n + 4 * q; const f32x4 o = *(const f32x4*)(base + c) + acc[n];
        *(f32x4*)(xo + c) = o; ss += (o[0] * o[0] + o[1] * o[1]) + (o[2] * o[2] + o[3] * o[3]);
        if (l == 0) { u32x2 w; w.x = pk2(o[0], o[1]); w.y = pk2(o[2], o[3]); *(u32x2*)(P_XB + (size_t)(TP + srow) * 1024 + c) = w; } }
    ss += __shfl_xor(ss, 16); ss += __shfl_xor(ss, 32);
    if (q == 0) P_ROWSS_S[(size_t)srow * 32 + u] = ss;
}

__device__ __forceinline__ f32x4 tile16T(const LAS bf16* A, int lda, const LAS bf16* Bt, int ldb, int K, int lane) {
    const LAS bf16* ap = A + (lane & 15) * lda + 8 * (lane >> 4);
    const LAS bf16* bp = Bt + (lane & 15) * ldb + 8 * (lane >> 4);
    f32x4 acc = {0.f, 0.f, 0.f, 0.f};
    for (int k0 = 0; k0 < K; k0 += 32) {
        const bf16x8 a = *(const LAS bf16x8*)(ap + k0), b = *(const LAS bf16x8*)(bp + k0);
        acc = __builtin_amdgcn_mfma_f32_16x16x32_bf16(b, a, acc, 0, 0, 0);
    }
    return acc;
}
template <int BR, int PH>
__device__ __forceinline__ void att_item(const Frame& F0, int l, int b, int ch, int h) {
    const Frame F = fresh(F0);
    constexpr int DK = (BR == 0) ? 64 : 32, NG = DK / 8, KS = DK + 64, NWV = DK / 8, RPW = 64 / NWV;
    constexpr int QOFF = BR == 0 ? C_HGQ : (BR == 1 ? C_GLQ : C_RTQ), KOFF = BR == 0 ? C_HGF : (BR == 1 ? C_GLK : C_RTK), VOFF = BR == 0 ? C_HGI : (BR == 1 ? C_GLV : C_RTV), ZOFF = BR == 0 ? C_HGZ : (BR == 1 ? C_GLZ : C_RTZ);
    constexpr int SOFF = BR == 0 ? 0 : (BR == 1 ? 16384 : 24576), DOFF = BR == 0 ? 0 : (BR == 1 ? 256 : 384);
    LAS unsigned char* L = F.lds;
    LAS float* WT = (LAS float*)(L + 0);
    LAS float* PART = (LAS float*)(L + 2048);
    LAS bf16* A1 = (LAS bf16*)(L + 4096);
    LAS bf16* B1 = (LAS bf16*)(L + 21504);
    LAS bf16* QH = (LAS bf16*)(L + 38912);
    LAS bf16* KH = (LAS bf16*)(L + 48128);
    LAS bf16* KT = (LAS bf16*)(L + 71168);
    LAS bf16* VT = (LAS bf16*)(L + 80384);
    const int tid = F.tid, lane = F.lane, wave = F.wave;
    const size_t row0 = (size_t)b * SEQ + (size_t)ch * CH;
    const bf16* proj = P_PROJ;
    const bool act = tid < 64 * NG;
    const int t = tid / NG, kg = tid % NG;
    const int tv = tid >> 3, vg = tid & 7;
    bf16x8 q8 = {}, k8 = {}, qp8 = {}, kp8 = {}; f32x4 g0 = {}, g1 = {}, rc0 = {}, rc1 = {}, rs0 = {}, rs1 = {}, lb0 = {}, lb1 = {};
    if (act) {
        const bf16* pr = proj + (row0 + t) * NPROJ;
        q8 = *(const bf16x8*)(pr + QOFF + h * DK + 8 * kg); k8 = *(const bf16x8*)(pr + KOFF + h * DK + 8 * kg);
        if (BR == 0) { const f32x4* lbp = (const f32x4*)(P_LB + l * 256 + h * 64 + 8 * kg); lb0 = lbp[0]; lb1 = lbp[1]; }
        if (BR == 1) { const f32x4* gp = (const f32x4*)(P_GG + (row0 + t) * 128 + h * 32 + 8 * kg); g0 = gp[0]; g1 = gp[1]; }
        if (BR == 2) { qp8 = *(const bf16x8*)(pr + QOFF + h * 32 + 8 * (kg ^ 2)); kp8 = *(const bf16x8*)(pr + KOFF + h * 32 + 8 * (kg ^ 2));
            const int pos = ch * CH + t; const f32x4* rc = (const f32x4*)(P_ROT + (size_t)pos * 16 + 8 * (kg & 1)); const f32x4* rsn = (const f32x4*)(P_ROT + 2049 * 16 + (size_t)pos * 16 + 8 * (kg & 1));
            rc0 = rc[0]; rc1 = rc[1]; rs0 = rsn[0]; rs1 = rsn[1]; }
    }
    const bf16x8 vv = *(const bf16x8*)(proj + (row0 + tv) * NPROJ + VOFF + h * 64 + 8 * vg);
    float* sl = P_SLOC + ((size_t)(b * NCH + ch) * 32768 + SOFF + (size_t)h * DK * 64);
    constexpr int NSP = DK * 64 / 4 / 512;
    f32x4 sp4[NSP] = {};
    const int ti = wave >> 1, vj0 = 2 * (wave & 1), fr = lane & 15, fq = lane >> 4;
    bf16x4 z4[2] = {}; f32x4 nw4[2] = {};
    if (PH == 4) {
#pragma unroll
        for (int n = 0; n < NSP; ++n) sp4[n] = *(const f32x4*)(sl + 4 * (tid + 512 * n));
        const float* nw = INP(BR == 0 ? I_HGNW : (BR == 1 ? I_GLNW : I_RTNW)) + l * 256 + h * 64;
#pragma unroll
        for (int e = 0; e < 2; ++e) { z4[e] = *(const bf16x4*)(proj + (row0 + 16 * ti + fr) * NPROJ + ZOFF + h * 64 + 16 * (vj0 + e) + 4 * fq); nw4[e] = *(const f32x4*)(nw + 16 * (vj0 + e) + 4 * fq); }
    }
    float qv[8], kv[8], bt[8];
    if (act) {
        if (BR == 0) { const float lbv[8] = {lb0[0], lb0[1], lb0[2], lb0[3], lb1[0], lb1[1], lb1[2], lb1[3]};
#pragma unroll
            for (int j = 0; j < 8; ++j) { const float x = bf2f(k8[j]), lb = lbv[j], e = __expf(-x), sg = rcpf_(1.0f + e), f = lb + (1.0f - lb) * sg;
                bt[j] = fmaxf(__logf(f), -60.f); kv[j] = (1.0f - lb) * e * sg; qv[j] = bf2f(q8[j]); }
        } else if (BR == 1) { const float gg[8] = {g0[0], g0[1], g0[2], g0[3], g1[0], g1[1], g1[2], g1[3]};
#pragma unroll
            for (int j = 0; j < 8; ++j) { bt[j] = gg[j]; qv[j] = bf2f(q8[j]) * 0.17677669529663687f; kv[j] = bf2f(k8[j]); }
        } else { const float cs[8] = {rc0[0], rc0[1], rc0[2], rc0[3], rc1[0], rc1[1], rc1[2], rc1[3]}, sn[8] = {rs0[0], rs0[1], rs0[2], rs0[3], rs1[0], rs1[1], rs1[2], rs1[3]};
            const float lg = __logf(1.0f - exp2f(-5.0f - (float)h));
#pragma unroll
            for (int j = 0; j < 8; ++j) { const float a = bf2f(q8[j]), pq = bf2f(qp8[j]), bk = bf2f(k8[j]), pk = bf2f(kp8[j]);
                qv[j] = kg < 2 ? a * cs[j] - pq * sn[j] : pq * sn[j] + a * cs[j];
                kv[j] = (kg < 2 ? bk * cs[j] - pk * sn[j] : pk * sn[j] + bk * cs[j]) * 0.17677669529663687f; bt[j] = lg; }
        }
        const int tl = lane / NG;
#pragma unroll
        for (int d = 1; d < RPW; d <<= 1) {
#pragma unroll
            for (int j = 0; j < 8; ++j) { const float up = __shfl_up(bt[j], d * NG); if (tl >= d) bt[j] += up; } }
    }
    bsync();
    if (act && (lane / NG) == RPW - 1) { *(LAS f32x4*)(WT + wave * 64 + 8 * kg) = (f32x4){bt[0], bt[1], bt[2], bt[3]}; *(LAS f32x4*)(WT + wave * 64 + 8 * kg + 4) = (f32x4){bt[4], bt[5], bt[6], bt[7]}; }
    bsync();
    float Bv[4][8], bl[8];
    if (act) {
        float run[8];
#pragma unroll
        for (int j = 0; j < 8; ++j) { run[j] = 0.f; Bv[0][j] = 0.f; }
        float own[8];
#pragma unroll
        for (int j = 0; j < 8; ++j) own[j] = 0.f;
#pragma unroll
        for (int w2 = 0; w2 < NWV; ++w2) {
            if (w2 == wave) {
#pragma unroll
                for (int j = 0; j < 8; ++j) own[j] = run[j]; }
            if (w2 * RPW == 16) {
#pragma unroll
                for (int j = 0; j < 8; ++j) Bv[1][j] = run[j]; }
            if (w2 * RPW == 32) {
#pragma unroll
                for (int j = 0; j < 8; ++j) Bv[2][j] = run[j]; }
            if (w2 * RPW == 48) {
#pragma unroll
                for (int j = 0; j < 8; ++j) Bv[3][j] = run[j]; }
            const f32x4 w0 = *(const LAS f32x4*)(WT + w2 * 64 + 8 * kg), w1 = *(const LAS f32x4*)(WT + w2 * 64 + 8 * kg + 4);
            run[0] += w0[0]; run[1] += w0[1]; run[2] += w0[2]; run[3] += w0[3]; run[4] += w1[0]; run[5] += w1[1]; run[6] += w1[2]; run[7] += w1[3];
        }
#pragma unroll
        for (int j = 0; j < 8; ++j) { bl[j] = run[j]; bt[j] += own[j]; }
    }
    if (PH == 2) {
        if (act) {
#pragma unroll
            for (int j = 0; j < 8; ++j) KT[(8 * kg + j) * 72 + t] = (bf16)f2bf(kv[j] * __expf(bl[j] - bt[j]));
            if (t == 63) { float* dp = P_DEC + (size_t)(b * NCH + ch) * 512 + DOFF + h * DK + 8 * kg;
                *(f32x4*)dp = (f32x4){__expf(bl[0]), __expf(bl[1]), __expf(bl[2]), __expf(bl[3])}; *(f32x4*)(dp + 4) = (f32x4){__expf(bl[4]), __expf(bl[5]), __expf(bl[6]), __expf(bl[7])}; }
        }
#pragma unroll
        for (int j = 0; j < 8; ++j) VT[(8 * vg + j) * 72 + tv] = (bf16)vv[j];
        bsync();
        constexpr int NTL = (DK / 16) * 4;
        for (int T = wave; T < NTL; T += 8) { const int ki = T >> 2, vj = T & 3;
            const f32x4 d = tile16(KT + 16 * ki * 72, 72, VT + 16 * vj * 72, 72, 64, lane);
#pragma unroll
            for (int r = 0; r < 4; ++r) sl[(16 * ki + 4 * fq + r) * 64 + 16 * vj + fr] = d[r]; }
    } else {
        if (act) {
            const int it = t >> 4; float o8[8];
#pragma unroll
            for (int j = 0; j < 8; ++j) o8[j] = qv[j] * __expf(bt[j]);
            *(LAS u32x4*)(A1 + t * 136 + 8 * kg) = pack8(o8);
#pragma unroll
            for (int i = 0; i < 4; ++i) {
                if (i >= it) {
                    if (i == it) {
#pragma unroll
                        for (int j = 0; j < 8; ++j) o8[j] = qv[j] * __expf(bt[j] - Bv[i][j]);
                        *(LAS u32x4*)(QH + t * 72 + 8 * kg) = pack8(o8);
                    }
#pragma unroll
                    for (int j = 0; j < 8; ++j) o8[j] = kv[j] * __expf(fminf(Bv[i][j] - bt[j], 80.f));
                    *(LAS u32x4*)(KH + (8 * i * (i + 1) + t) * 72 + 8 * kg) = pack8(o8);
                }
            }
        }
#pragma unroll
        for (int j = 0; j < 8; ++j) B1[(8 * vg + j) * 136 + DK + tv] = (bf16)vv[j];
#pragma unroll
        for (int n = 0; n < NSP; ++n) { const int idx = 4 * (tid + 512 * n), k = idx >> 6, v = idx & 63;
#pragma unroll
            for (int j = 0; j < 4; ++j) B1[(v + j) * 136 + k] = (bf16)f2bf(sp4[n][j]); }
        bsync();
#pragma unroll
        for (int e = 0; e < 2; ++e) { const int T = 2 * wave + e, i = T >> 2, j = T & 3;
            f32x4 d = {0.f, 0.f, 0.f, 0.f};
            if (j <= i) d = tile16(QH + 16 * i * 72, 72, KH + (8 * i * (i + 1) + 16 * j) * 72, 72, DK, lane);
#pragma unroll
            for (int r = 0; r < 4; ++r) { const int tt = 4 * fq + r; const float val = (j < i || (j == i && fr <= tt)) ? d[r] : 0.f;
                A1[(16 * i + tt) * 136 + DK + 16 * j + fr] = (bf16)f2bf(val); } }
        bsync();
        f32x4 o[2];
#pragma unroll
        for (int e = 0; e < 2; ++e) o[e] = tile16T(A1 + 16 * ti * 136, 136, B1 + 16 * (vj0 + e) * 136, 136, KS, lane);
        float s1 = 0.f, s2 = 0.f;
#pragma unroll
        for (int e = 0; e < 2; ++e)
#pragma unroll
            for (int r = 0; r < 4; ++r) { s1 += o[e][r]; s2 += o[e][r] * o[e][r]; }
        s1 += __shfl_xor(s1, 16); s1 += __shfl_xor(s1, 32); s2 += __shfl_xor(s2, 16); s2 += __shfl_xor(s2, 32);
        if (fq == 0) *(LAS f32x2*)(PART + ((16 * ti + fr) * 2 + (wave & 1)) * 2) = (f32x2){s1, s2};
        bsync();
        {
            const f32x4 pp = *(const LAS f32x4*)(PART + (16 * ti + fr) * 4);
            const float S = pp[0] + pp[2], SS = pp[1] + pp[3];
            float mean = 0.f, var = SS * (1.0f / 64.0f);
            if (BR == 2) { mean = S * (1.0f / 64.0f); var -= mean * mean; }
            const float rstd = rsqrtf(fmaxf(var, 0.f) + EPS);
#pragma unroll
            for (int e = 0; e < 2; ++e) { float y[4];
#pragma unroll
                for (int r = 0; r < 4; ++r) y[r] = (o[e][r] - mean) * rstd * nw4[e][r] * siluf_(bf2f(z4[e][r]));
                u32x2 w; w.x = pk2(y[0], y[1]); w.y = pk2(y[2], y[3]);
                *(u32x2*)(P_MIX + (row0 + 16 * ti + fr) * 1024 + 256 * (BR + 1) + h * 64 + 16 * (vj0 + e) + 4 * fq) = w; }
        }
    }
}

__device__ __forceinline__ int s5idx(int t, int n) { return t * 128 + ((((n >> 3) ^ (t & 7))) << 3) + (n & 7); }
template <int PH>
__device__ __forceinline__ void s5_item(const Frame& F0, int l, int b, int ch) {
    const Frame F = fresh(F0);
    LAS unsigned char* L = F.lds;
    const int lane = F.lane, wave = F.wave;
    LAS bf16* SR = (LAS bf16*)(L + wave * 16384);
    const size_t row0 = (size_t)b * SEQ + (size_t)ch * CH;
    const bf16* proj = P_PROJ;
    bsync();
    f32x4 yacc[2][4];
#pragma unroll
    for (int rd = 0; rd < 2; ++rd) {
        const int g = wave + 8 * rd;
        const bf16* bbt = P_BBT + (size_t)(l * 16 + g) * 128 * 16;
#pragma unroll
        for (int tt = 0; tt < 2; ++tt) {
            const bf16x8 a = *(const bf16x8*)(proj + (row0 + 32 * tt + (lane & 31)) * NPROJ + C_S5U + 16 * g + 8 * (lane >> 5));
#pragma unroll
            for (int nn = 0; nn < 4; ++nn) {
                const bf16x8 bq = *(const bf16x8*)(bbt + (32 * nn + (lane & 31)) * 16 + 8 * (lane >> 5));
                f32x16 d;
#pragma unroll
                for (int i = 0; i < 16; ++i) d[i] = 0.f;
                d = __builtin_amdgcn_mfma_f32_32x32x16_bf16(a, bq, d, 0, 0, 0);
#pragma unroll
                for (int i = 0; i < 16; ++i) { const int tr = 32 * tt + (i & 3) + 8 * (i >> 2) + 4 * (lane >> 5), n = 32 * nn + (lane & 31); SR[s5idx(tr, n)] = (bf16)f2bf(d[i]); }
            }
        }
        LDS_WAIT();
        {
            const f32x4 av = *(const f32x4*)(P_S5A + (size_t)((l * 16 + g) * 64 + lane) * 4);
            const float ar = av[0], ai = av[1];
            float* s5l = P_S5LOC + ((size_t)(b * NCH + ch) * 16 + g) * 128 + 2 * lane;
            float sr = 0.f, si = 0.f;
            if (PH == 4) { const f32x2 s0 = *(const f32x2*)s5l; sr = s0[0]; si = s0[1]; }
            for (int t0 = 0; t0 < 64; t0 += 8) {
                float brv[8], biv[8];
#pragma unroll
                for (int u = 0; u < 8; ++u) { brv[u] = bf2f((short)SR[s5idx(t0 + u, lane)]); biv[u] = bf2f((short)SR[s5idx(t0 + u, 64 + lane)]); }
#pragma unroll
                for (int u = 0; u < 8; ++u) { const float nr = __builtin_fmaf(ar, sr, __builtin_fmaf(-ai, si, brv[u])), ni = __builtin_fmaf(ar, si, __builtin_fmaf(ai, sr, biv[u])); sr = nr; si = ni; brv[u] = nr; biv[u] = ni; }
                if (PH == 4) {
#pragma unroll
                    for (int u = 0; u < 8; ++u) { SR[s5idx(t0 + u, lane)] = (bf16)f2bf(brv[u]); SR[s5idx(t0 + u, 64 + lane)] = (bf16)f2bf(biv[u]); } }
            }
            if (PH == 2) *(f32x2*)s5l = (f32x2){sr, si};
        }
        if (PH == 4) {
            LDS_WAIT();
            const bf16* ccn = P_CCN + (size_t)(l * 16 + g) * 16 * 128;
            bf16x8 bfr[4];
#pragma unroll
            for (int ks = 0; ks < 4; ++ks) bfr[ks] = *(const bf16x8*)(ccn + (lane & 15) * 128 + 32 * ks + 8 * (lane >> 4));
#pragma unroll
            for (int ti = 0; ti < 4; ++ti) { f32x4 acc = {0.f, 0.f, 0.f, 0.f};
#pragma unroll
                for (int ks = 0; ks < 4; ++ks) { const bf16x8 afr = *(const LAS bf16x8*)(SR + s5idx(16 * ti + (lane & 15), 32 * ks + 8 * (lane >> 4)));
                    acc = __builtin_amdgcn_mfma_f32_16x16x32_bf16(bfr[ks], afr, acc, 0, 0, 0); }
                yacc[rd][ti] = acc; }
            LDS_WAIT();
        }
    }
    if (PH == 4) {
        bsync();
        LAS bf16* YB = (LAS bf16*)L;
#pragma unroll
        for (int rd = 0; rd < 2; ++rd) { const int g = wave + 8 * rd;
#pragma unroll
            for (int ti = 0; ti < 4; ++ti) { const int t = 16 * ti + (lane & 15), c0 = 16 * g + 4 * (lane >> 4);
                const bf16x4 u4 = *(const bf16x4*)(proj + (row0 + t) * NPROJ + C_S5U + c0);
                const f32x4 dsk = *(const f32x4*)(INP(I_S5D) + l * 256 + c0);
                float y[4];
#pragma unroll
                for (int j = 0; j < 4; ++j) y[j] = gelu_tanh(yacc[rd][ti][j] + dsk[j] * bf2f(u4[j]));
                u32x2 w; w.x = pk2(y[0], y[1]); w.y = pk2(y[2], y[3]);
                *(LAS u32x2*)(YB + t * 264 + c0) = w; } }
        bsync();
        const bf16* wg = P_WGLU + (size_t)l * 256 * 256;
#pragma unroll
        for (int nt = 0; nt < 2; ++nt) { const int ntile = 2 * wave + nt;
            f32x4 acc[4];
#pragma unroll
            for (int ti = 0; ti < 4; ++ti) acc[ti] = (f32x4){0.f, 0.f, 0.f, 0.f};
#pragma unroll 2
            for (int ks = 0; ks < 8; ++ks) {
                const bf16x8 bfr = *(const bf16x8*)(wg + (size_t)(16 * ntile + (lane & 15)) * 256 + 32 * ks + 8 * (lane >> 4));
#pragma unroll
                for (int ti = 0; ti < 4; ++ti) { const bf16x8 afr = *(const LAS bf16x8*)(YB + (16 * ti + (lane & 15)) * 264 + 32 * ks + 8 * (lane >> 4));
                    acc[ti] = __builtin_amdgcn_mfma_f32_16x16x32_bf16(bfr, afr, acc[ti], 0, 0, 0); }
            }
#pragma unroll
            for (int ti = 0; ti < 4; ++ti) {
                const int t = 16 * ti + (lane & 15), n0 = 16 * ntile + 4 * (lane >> 4);
                const bf16x4 y4 = *(const LAS bf16x4*)(YB + t * 264 + n0);
                const bf16x4 z4 = *(const bf16x4*)(proj + (row0 + t) * NPROJ + C_S5Z + n0);
                float o[4];
#pragma unroll
                for (int j = 0; j < 4; ++j) o[j] = bf2f(y4[j]) * sigmoidf_(acc[ti][j]) * siluf_(bf2f(z4[j]));
                u32x2 w; w.x = pk2(o[0], o[1]); w.y = pk2(o[2], o[3]);
                *(u32x2*)(P_MIX + (row0 + t) * 1024 + n0) = w; } }
    }
}

__device__ __forceinline__ void p3_carry(const Frame& F0, int l) {
    const Frame F = fresh(F0);
    const int gt = F.bid * 512 + F.tid, NGT = F.G * 512;
    for (int e = gt; e < NBATCH * 32768; e += NGT) {
        const int b = e >> 15, r = e & 32767;
        int di; size_t oo;
        if (r < 16384) { di = r >> 6; oo = O_HG_P + (size_t)(l * 8 + b) * 16384 + r; }
        else if (r < 24576) { di = 256 + ((r - 16384) >> 6); oo = O_GLA_P + (size_t)(l * 8 + b) * 8192 + (r - 16384); }
        else { di = 384 + ((r - 24576) >> 6); oo = O_RET_P + (size_t)(l * 8 + b) * 8192 + (r - 24576); }
        float* sp = P_SLOC + (size_t)b * NCH * 32768 + r; const float* dp = P_DEC + (size_t)b * NCH * 512 + di;
        float S = 0.f;
        for (int c0 = 0; c0 < NCH; c0 += 16) {
            float hv[16], dv[16];
#pragma unroll
            for (int c = 0; c < 16; ++c) { hv[c] = sp[(size_t)(c0 + c) * 32768]; dv[c] = dp[(size_t)(c0 + c) * 512]; }
#pragma unroll
            for (int c = 0; c < 16; ++c) { sp[(size_t)(c0 + c) * 32768] = S; S = dv[c] * S + hv[c]; }
        }
        OUTP[oo] = S;
    }
    for (int e = gt; e < NBATCH * 1024; e += NGT) {
        const int b = e >> 10, gp = e & 1023;
        const f32x4 av = *(const f32x4*)(P_S5A + (size_t)(l * 1024 + gp) * 4); const float a64r = av[2], a64i = av[3];
        float* sp = P_S5LOC + (size_t)b * NCH * 2048 + 2 * gp;
        float sr = 0.f, si = 0.f;
        for (int c = 0; c < NCH; ++c) { const f32x2 hv = *(const f32x2*)(sp + (size_t)c * 2048); *(f32x2*)(sp + (size_t)c * 2048) = (f32x2){sr, si};
            const float nr = a64r * sr - a64i * si + hv[0], ni = a64r * si + a64i * sr + hv[1]; sr = nr; si = ni; }
        OUTP[O_S5RE_P + (size_t)(l * 8 + b) * 1024 + gp] = sr; OUTP[O_S5IM_P + (size_t)(l * 8 + b) * 1024 + gp] = si;
    }
}

template <int BR>
__device__ __forceinline__ void samp_att_item(const Frame& F0, int l, int sb, int h) {
    const Frame F = fresh(F0);
    constexpr int DK = (BR == 0) ? 64 : 32, KPS = DK / 8;
    constexpr int QOFF = BR == 0 ? C_HGQ : (BR == 1 ? C_GLQ : C_RTQ), KOFF = BR == 0 ? C_HGF : (BR == 1 ? C_GLK : C_RTK), VOFF = BR == 0 ? C_HGI : (BR == 1 ? C_GLV : C_RTV), ZOFF = BR == 0 ? C_HGZ : (BR == 1 ? C_GLZ : C_RTZ);
    LAS float* QS = (LAS float*)(F.lds + 0);
    LAS float* KSV = (LAS float*)(F.lds + 256);
    LAS float* EG = (LAS float*)(F.lds + 512);
    LAS float* VS = (LAS float*)(F.lds + 768);
    LAS float* PART = (LAS float*)(F.lds + 1024);
    const int tid = F.tid;
    const bf16* pr = P_PROJ + (size_t)(TP + sb) * NPROJ;
    bsync();
    if (tid < DK) {
        const int c = tid;
        if (BR == 0) { const float x = bf2f((short)pr[KOFF + h * 64 + c]), lb = P_LB[l * 256 + h * 64 + c], e = __expf(-x), sg = rcpf_(1.0f + e);
            EG[c] = lb + (1.0f - lb) * sg; KSV[c] = (1.0f - lb) * e * sg; QS[c] = bf2f((short)pr[QOFF + h * 64 + c]); }
        else if (BR == 1) { EG[c] = __expf(P_GG[(size_t)(TP + sb) * 128 + h * 32 + c]); QS[c] = bf2f((short)pr[QOFF + h * 32 + c]) * 0.17677669529663687f; KSV[c] = bf2f((short)pr[KOFF + h * 32 + c]); }
        else { const int j = c & 15; const float cs = P_ROT[2048 * 16 + j], sn = P_ROT[2049 * 16 + 2048 * 16 + j];
            const float q1 = bf2f((short)pr[QOFF + h * 32 + j]), q2 = bf2f((short)pr[QOFF + h * 32 + 16 + j]), k1 = bf2f((short)pr[KOFF + h * 32 + j]), k2 = bf2f((short)pr[KOFF + h * 32 + 16 + j]);
            QS[c] = c < 16 ? q1 * cs - q2 * sn : q1 * sn + q2 * cs; KSV[c] = (c < 16 ? k1 * cs - k2 * sn : k1 * sn + k2 * cs) * 0.17677669529663687f;
            EG[c] = 1.0f - exp2f(-5.0f - (float)h); }
    }
    if (tid >= 64 && tid < 128) VS[tid - 64] = bf2f((short)pr[VOFF + h * 64 + (tid - 64)]);
    bsync();
    const int v = tid & 63, ksl = tid >> 6;
    const size_t sbase = ((size_t)(l * NS + sb) * 4 + h) * DK * 64;
    const float* s0 = INP(BR == 0 ? I_SHG : (BR == 1 ? I_SGLA : I_SRET)) + sbase;
    float* s1 = OUTP + (BR == 0 ? O_HG_S : (BR == 1 ? O_GLA_S : O_RET_S)) + sbase;
    float acc = 0.f; const float vvv = VS[v];
#pragma unroll
    for (int kk = 0; kk < KPS; ++kk) { const int k = ksl * KPS + kk; const float sn = EG[k] * s0[k * 64 + v] + KSV[k] * vvv; s1[k * 64 + v] = sn; acc += QS[k] * sn; }
    PART[ksl * 64 + v] = acc;
    bsync();
    if (tid < 64) {
        float o = 0.f;
#pragma unroll
        for (int s = 0; s < 8; ++s) o += PART[s * 64 + tid];
        if (BR == 2) o -= wave_sum(o) * (1.0f / 64.0f);
        const float rstd = 1.0f / sqrtf(wave_sum(o * o) * (1.0f / 64.0f) + EPS);
        const float nw = INP(BR == 0 ? I_HGNW : (BR == 1 ? I_GLNW : I_RTNW))[l * 256 + h * 64 + tid];
        const float z = bf2f((short)pr[ZOFF + h * 64 + tid]);
        P_MIX[(size_t)(TP + sb) * 1024 + 256 * (BR + 1) + h * 64 + tid] = (bf16)f2bf(o * rstd * nw * siluf_(z));
    }
}
__device__ __forceinline__ void samp_s5_item(const Frame& F0, int l, int sb) {
    const Frame F = fresh(F0);
    LAS float* US = (LAS float*)(F.lds + 0);
    LAS float* SS = (LAS float*)(F.lds + 1024);
    LAS float* YS = (LAS float*)(F.lds + 1024 + 8192);
    const int tid = F.tid;
    const bf16* pr = P_PROJ + (size_t)(TP + sb) * NPROJ;
    bsync();
    if (tid < 256) US[tid] = bf2f((short)pr[C_S5U + tid]);
    bsync();
    for (int idx = tid; idx < 1024; idx += 512) { const int g = idx >> 6, p = idx & 63;
        const bf16* bb = P_BBT + (size_t)(l * 16 + g) * 128 * 16; float br = 0.f, bi = 0.f;
#pragma unroll
        for (int c = 0; c < 16; ++c) { const float u = US[16 * g + c]; br += bf2f((short)bb[p * 16 + c]) * u; bi += bf2f((short)bb[(64 + p) * 16 + c]) * u; }
        const f32x4 av = *(const f32x4*)(P_S5A + (size_t)(l * 1024 + idx) * 4);
        const size_t si = (size_t)(l * NS + sb) * 1024 + idx;
        const float s0r = INP(I_S5RE)[si], s0i = INP(I_S5IM)[si];
        const float nr = av[0] * s0r - av[1] * s0i + br, ni = av[0] * s0i + av[1] * s0r + bi;
        OUTP[O_S5RE_S + si] = nr; OUTP[O_S5IM_S + si] = ni; SS[g * 128 + p] = nr; SS[g * 128 + 64 + p] = ni; }
    bsync();
    if (tid < 256) { const int g = tid >> 4, c = tid & 15; const bf16* cc = P_CCN + (size_t)(l * 16 + g) * 16 * 128 + c * 128; float y = 0.f;
        for (int n = 0; n < 128; ++n) y += bf2f((short)cc[n]) * SS[g * 128 + n];
        YS[tid] = gelu_tanh(y + INP(I_S5D)[l * 256 + tid] * US[tid]); }
    bsync();
    if (tid < 256) { const bf16* wg = P_WGLU + (size_t)l * 256 * 256 + (size_t)tid * 256; float gl = 0.f;
        for (int c8 = 0; c8 < 32; ++c8) { const bf16x8 w = *(const bf16x8*)(wg + 8 * c8);
#pragma unroll
            for (int j = 0; j < 8; ++j) gl += bf2f(w[j]) * YS[8 * c8 + j]; }
        const float z = bf2f((short)pr[C_S5Z + tid]);
        P_MIX[(size_t)(TP + sb) * 1024 + tid] = (bf16)f2bf(YS[tid] * sigmoidf_(gl) * siluf_(z)); }
}

__device__ __forceinline__ void final_norm(const Frame& F0) {
    const Frame F = fresh(F0);
    const int gw = F.bid * NWAVES + F.wave, NGW = F.G * NWAVES, lane = F.lane;
    for (int m = gw; m < TT; m += NGW) {
        float* row = m < TP ? OUTP + O_YP + (size_t)m * DM : OUTP + O_YS + (size_t)(m - TP) * DM;
        f32x4* xr = (f32x4*)row + lane; f32x4 v[4]; float s = 0.f;
#pragma unroll
        for (int j = 0; j < 4; ++j) { v[j] = xr[64 * j]; s += (v[j][0] * v[j][0] + v[j][1] * v[j][1]) + (v[j][2] * v[j][2] + v[j][3] * v[j][3]); }
        const float rstd = 1.0f / sqrtf(wave_sum(s) * (1.0f / 1024.0f) + EPS);
        const f32x4* wr = (const f32x4*)INP(I_FNORMW) + lane;
#pragma unroll
        for (int j = 0; j < 4; ++j) xr[64 * j] = v[j] * rstd * wr[64 * j];
    }
}

__global__ void __launch_bounds__(NWAVES * 64, 2) __attribute__((target("no-packed-fp32-ops"))) mk_fwd(Args args) {
    extern __shared__ __attribute__((aligned(16))) unsigned char lds[];
    Frame F;
    F.lds = (LAS unsigned char*)lds;
    F.tid = threadIdx.x; F.lane = F.tid & 63; F.wave = __builtin_amdgcn_readfirstlane(F.tid >> 6); F.G = gridDim.x; F.bid = blockIdx.x; F.kp = (KargPtr)__builtin_amdgcn_kernarg_segment_ptr();
    unsigned char* ws = args.ws;
    volatile LAS unsigned* MISC = (volatile LAS unsigned*)(F.lds + MISC_OFF);
    for (int u = F.tid; u < (LDS_BYTES - LDSCTL_OFF) / 4; u += NWAVES * 64) ((LAS unsigned*)(F.lds + LDSCTL_OFF))[u] = 0u;
    bsync();
    unsigned* barw = (unsigned*)(ws + WS_CTL) + CW_BAR;
    XcdBarrier bar; bar.bar = barw; bar.x = 0; bar.st = nullptr;
    if (N_LAUNCHES == 1) bar = xcd_barrier_post(barw, MISC + 8);
    const int lo = args.ph_lo, hi = args.ph_hi;
#define IN(k) (lo <= (k) && (k) < hi)
#define SEAM(k) do { if (IN(k) && IN((k) + 1)) xcd_barrier(bar); } while (0)

    if (IN(0)) { p0_prologue(F, 7); if ((DUP_MASK) >> 7) p0_prologue(F, (DUP_MASK) >> 7); }
    SEAM(0);
#pragma unroll 1
    for (int l = 0; l < 2; ++l) {
        const int pb = 1 + 5 * l;
        if (IN(pb)) {
            pg8::Gemm g{P_XB, P_WIN + (size_t)l * NPROJ * 1024, TP, NPROJ, DM}; pg8::StaticOrder S; S.init(TP, NPROJ, F.G, F.bid);
            pg8::EpiProj E{P_PROJ, P_ROWSS};
            for (int rep = 0; rep < NREP(1); ++rep) pg8::gemm_phase<pg8::EpiProj, pg8::StaticOrder, true, true>(F.lds, g, S, E);
            for (int rep = 0; rep < NREP(5); ++rep) for (int u = F.bid; u < N_G1_SMALL; u += F.G) g1_small_unit(F, l, u);
        }
        SEAM(pb);
        if (IN(pb + 1)) {
            for (int rep = 0; rep < NREP(2); ++rep)
            for (int it = F.bid; it < NBC; it += F.G) { const int b = it / NCH, ch = it % NCH;
#pragma unroll 1
                for (int h = 0; h < 4; ++h) att_item<0, 2>(F, l, b, ch, h);
#pragma unroll 1
                for (int h = 0; h < 4; ++h) att_item<1, 2>(F, l, b, ch, h);
#pragma unroll 1
                for (int h = 0; h < 4; ++h) att_item<2, 2>(F, l, b, ch, h);
                s5_item<2>(F, l, b, ch); }
        }
        SEAM(pb + 1);
        if (IN(pb + 2)) p3_carry(F, l);
        SEAM(pb + 2);
        if (IN(pb + 3)) {
            for (int rep = 0; rep < NREP(3); ++rep)
            for (int it = F.bid; it < NBC; it += F.G) { const int b = it / NCH, ch = it % NCH;
#pragma unroll 1
                for (int h = 0; h < 4; ++h) att_item<0, 4>(F, l, b, ch, h);
#pragma unroll 1
                for (int h = 0; h < 4; ++h) att_item<1, 4>(F, l, b, ch, h);
#pragma unroll 1
                for (int h = 0; h < 4; ++h) att_item<2, 4>(F, l, b, ch, h);
                s5_item<4>(F, l, b, ch); }
            for (int rep = 0; rep < NREP(6); ++rep)
            for (int it = F.bid; it < NS * 13; it += F.G) { const int sb = it / 13, sub = it % 13;
                if (sub < 4) samp_att_item<0>(F, l, sb, sub); else if (sub < 8) samp_att_item<1>(F, l, sb, sub - 4); else if (sub < 12) samp_att_item<2>(F, l, sb, sub - 8); else samp_s5_item(F, l, sb); }
        }
        SEAM(pb + 3);
        if (IN(pb + 4)) {
            pg8::Gemm g{P_MIX, P_WOUT + (size_t)l * 1024 * 1024, TP, DM, DM}; pg8::StaticOrder S; S.init(TP, DM, F.G, F.bid);
            pg8::EpiRes E{l == 0 ? INP(I_XP) : OUTP + O_YP, OUTP + O_YP, l == 0 ? P_XB : nullptr, P_ROWSS};
            for (int rep = 0; rep < (l == 0 ? NREP(4) : 1); ++rep) pg8::gemm_phase<pg8::EpiRes, pg8::StaticOrder, false, true>(F.lds, g, S, E);
            for (int u = F.bid; u < 32; u += F.G) g2_small_unit(F, l, u);
        }
        SEAM(pb + 4);
    }
    if (IN(11)) final_norm(F);
#undef IN
#undef SEAM
}

extern "C" void kernel_launch(void* const* d_in, const int* in_sizes, int n_in, void* d_out, int out_size, void* d_ws, size_t ws_size, hipStream_t stream) {
    static int grid = 0;
    if (grid == 0) {
        if (n_in != N_INPUTS || in_sizes[0] != TP * DM || (size_t)out_size != O_END || ws_size < WS_END) { fprintf(stderr, "kernel_launch: unexpected shapes (n_in %d, in0 %d, out %d, ws %zu)\n", n_in, n_in > 0 ? in_sizes[0] : -1, out_size, ws_size); grid = -1; return; }
        int dev = 0, cus = 0, per_cu = 0;
        if (hipGetDevice(&dev) != hipSuccess || hipDeviceGetAttribute(&cus, hipDeviceAttributeMultiprocessorCount, dev) != hipSuccess) { grid = -1; return; }
        if (hipFuncSetAttribute((const void*)mk_fwd, hipFuncAttributeMaxDynamicSharedMemorySize, LDS_BYTES) != hipSuccess) { fprintf(stderr, "kernel_launch: hipFuncSetAttribute failed\n"); grid = -1; return; }
        if (hipOccupancyMaxActiveBlocksPerMultiprocessor(&per_cu, (const void*)mk_fwd, NWAVES * 64, LDS_BYTES) != hipSuccess || per_cu < 1) fprintf(stderr, "kernel_launch: occupancy query says %d\n", per_cu);
        (void)hipGetLastError();
        grid = cus < 256 ? cus : 256;
    }
    if (grid < 0) return;
    if (hipMemsetAsync((char*)d_ws + WS_CTL, 0, CTL_ZERO_BYTES, stream) != hipSuccess) return;
    Args a{};
    for (int i = 0; i < N_INPUTS; ++i) a.in[i] = (const float*)d_in[i];
    a.out = (float*)d_out; a.ws = (unsigned char*)d_ws;
    for (int li = 0; li < N_LAUNCHES; ++li) {
        a.ph_lo = (N_LAUNCHES == 1) ? 0 : li; a.ph_hi = (N_LAUNCHES == 1) ? N_PHASES : li + 1; a.li = li;
        hipLaunchKernelGGL(mk_fwd, dim3(grid), dim3(NWAVES * 64), LDS_BYTES, stream, a);
    }
}
```

```cpp
#include <hip/hip_runtime.h>
#include <cstdio>
#include <cstdint>
namespace pg8 {
#define PG8_LAS __attribute__((address_space(3)))
typedef unsigned short bf16_t;
typedef short bf16x8 __attribute__((ext_vector_type(8)));
typedef float f32x4 __attribute__((ext_vector_type(4)));
typedef unsigned u32x4 __attribute__((ext_vector_type(4)));
constexpr int BM = 256, BK = 64, HALF = 128, HTB = HALF * BK * 2  , STAGE_BYTES = 8 * HTB, NXCD = 8, WGM = 8;

__host__ __device__ __forceinline__ int lds_byte(int r, int c) { const int st = (r >> 4) * 2 + (c >> 5), rr = r & 15, cc = c & 31, ob = rr * 64 + cc * 2; return st * 1024 + (ob ^ (((ob >> 9) & 1) << 5)); }
__host__ __device__ __forceinline__ void stage_rc(int b, int& R, int& C) { const int st = b / 1024, sb = b % 1024, swz = sb ^ (((sb >> 9) & 1) << 5); R = (st >> 1) * 16 + swz / 64; C = (st & 1) * 32 + (swz % 64) / 2; }
__host__ __device__ __forceinline__ int perm32(int rho) { const int n = rho >> 4, i = rho & 15; return 8 * (i >> 2) + 4 * n + (i & 3); }

struct Unit { int pm, pn; };
struct Gemm { const bf16_t* A; const bf16_t* Bt; int M, N, K; };

struct StaticOrder {
    int nM, nN, nwg, G, c;
    __host__ __device__ __forceinline__ void init(int M, int N, int G_, int c_) { nM = M / BM; nN = N / BM; nwg = nM * nN; G = G_; c = c_; }
    __host__ __device__ __forceinline__ bool next(int i, Unit& u) const {
        const long L = (long)i * G + c; if (L >= nwg) return false;
        int wgid = (int)L; { const int q = nwg / NXCD, r = nwg % NXCD, xcd = wgid % NXCD, off = wgid / NXCD; wgid = (xcd < r ? xcd * (q + 1) : r * (q + 1) + (xcd - r) * q) + off; }
        const int nig = WGM * nN, gid = wgid / nig, fm = gid * WGM, gsz = (nM - fm) < WGM ? (nM - fm) : WGM;
        u.pm = fm + ((wgid % nig) % gsz); u.pn = (wgid % nig) / gsz; return true;
    }
    __device__ __forceinline__ void a_ready(const Unit&) const {}
    __device__ __forceinline__ void done(const Unit&) const {}
};
__device__ __forceinline__ unsigned cvt_pk_bf16(float lo, float hi) { unsigned r; asm volatile("v_cvt_pk_bf16_f32 %0, %1, %2" : "=v"(r) : "v"(lo), "v"(hi)); return r; }
template <class Epi, class Sched, bool ALIGN_EPI = false, bool SP2 = false>
__device__ __forceinline__ void gemm_phase(PG8_LAS unsigned char* lds, const Gemm g, const Sched& S, const Epi& E) {
    int tid_ = threadIdx.x; asm volatile("" : "+v"(tid_)); const int tid = tid_, wid = __builtin_amdgcn_readfirstlane(tid >> 6), lane = tid & 63, wr = wid >> 2, wc = wid & 3, fr = lane & 15, fq = lane >> 4;
    const int K = g.K, nt = K / BK;
    unsigned voffA[2], voffB[2];
#pragma unroll
    for (int i = 0; i < 2; ++i) { int R, C; stage_rc(tid * 16 + i * 8192, R, C); const int Rb = Epi::PERM ? ((R & ~31) + perm32(R & 31)) : R;
        voffA[i] = (unsigned)(R * K + C) * 2u; voffB[i] = (unsigned)(Rb * K + C) * 2u; }
    const size_t kstep = (size_t)(BK * 2);
    const size_t hstep = (size_t)HALF * K * 2;
    const size_t tstep = 2 * hstep;
    const unsigned ldsw = (unsigned)wid * 1024u;
    const int aoff = lds_byte(wr * 64 + fr, fq * 8), boff = lds_byte(wc * 32 + fr, fq * 8);
#define PG8_SA(b, h) (((b) * 2 + (h)) * HTB)
#define PG8_SB(b, h) ((4 + (b) * 2 + (h)) * HTB)
#define PG8_STAGE(bufoff, gbase, voff) do { _Pragma("unroll") for (int _i = 0; _i < 2; ++_i) \
        __builtin_amdgcn_global_load_lds((const unsigned*)((const char*)(gbase) + (voff)[_i]), (PG8_LAS unsigned*)(lds + (bufoff) + ldsw + _i * 8192), 16, 0, 0); } while (0)
#define PG8_LDA(dst, b, h) do { _Pragma("unroll") for (int m = 0; m < 4; ++m) _Pragma("unroll") for (int k = 0; k < 2; ++k) dst[m][k] = *(const PG8_LAS bf16x8*)(lds + PG8_SA(b, h) + aoff + m * 2048 + k * 1024); } while (0)
#define PG8_LDB(dst, b, h) do { _Pragma("unroll") for (int n = 0; n < 2; ++n) _Pragma("unroll") for (int k = 0; k < 2; ++k) dst[n][k] = *(const PG8_LAS bf16x8*)(lds + PG8_SB(b, h) + boff + n * 2048 + k * 1024); } while (0)
#define PG8_MMA(ai, bj, At, Bt) do { __builtin_amdgcn_s_setprio(1); _Pragma("unroll") for (int m = 0; m < 4; ++m) _Pragma("unroll") for (int n = 0; n < 2; ++n) _Pragma("unroll") for (int k = 0; k < 2; ++k) \
        acc[ai][bj][m][n] = __builtin_amdgcn_mfma_f32_16x16x32_bf16(Bt[n][k], At[m][k], acc[ai][bj][m][n], 0, 0, 0); __builtin_amdgcn_s_setprio(0); } while (0)
#define PG8_WAIT_V(n) asm volatile("s_waitcnt vmcnt(" #n ")" ::: "memory")
#define PG8_WAIT_L(n) asm volatile("s_waitcnt lgkmcnt(" #n ")" ::: "memory")
#define PG8_BAR __builtin_amdgcn_s_barrier()
#define PG8_SCHED __builtin_amdgcn_sched_barrier(0)
    Unit cur, nxt; int ui = 0;
    if (!S.next(0, cur)) return;
    f32x4 acc[2][2][4][2];
#pragma unroll
    for (int a = 0; a < 2; ++a)
#pragma unroll
        for (int b = 0; b < 2; ++b)
#pragma unroll
            for (int m = 0; m < 4; ++m)
#pragma unroll
                for (int n = 0; n < 2; ++n) acc[a][b][m][n] = (f32x4){0.f, 0.f, 0.f, 0.f};
    bf16x8 At[4][2], B0[2][2], B1[2][2];
    const char* cA = (const char*)g.A + (size_t)cur.pm * tstep; const char* cB = (const char*)g.Bt + (size_t)cur.pn * tstep;
    S.a_ready(cur);
    if constexpr (SP2) {
        PG8_STAGE(PG8_SB(0, 0), cB, voffB); PG8_STAGE(PG8_SB(0, 1), cB + hstep, voffB); PG8_STAGE(PG8_SA(0, 0), cA, voffA); PG8_STAGE(PG8_SA(0, 1), cA + hstep, voffA);
        if (wr == 1) PG8_BAR;
        PG8_WAIT_V(2); PG8_BAR;
        PG8_STAGE(PG8_SB(1, 0), cB + kstep, voffB); PG8_STAGE(PG8_SA(1, 0), cA + kstep, voffA); PG8_STAGE(PG8_SB(1, 1), cB + hstep + kstep, voffB);
        PG8_WAIT_V(6); PG8_BAR;
    } else {
        PG8_STAGE(PG8_SB(0, 0), cB, voffB); PG8_STAGE(PG8_SA(0, 0), cA, voffA); PG8_STAGE(PG8_SB(0, 1), cB + hstep, voffB); PG8_STAGE(PG8_SA(0, 1), cA + hstep, voffA);
        if (wr == 1) PG8_BAR;
        PG8_WAIT_V(4); PG8_BAR;
        PG8_STAGE(PG8_SB(1, 0), cB + kstep, voffB); PG8_STAGE(PG8_SA(1, 0), cA + kstep, voffA); PG8_STAGE(PG8_SB(1, 1), cB + hstep + kstep, voffB);
        PG8_WAIT_V(6); PG8_BAR;
    }
    for (;;) {
        const bool has_next = S.next(ui + 1, nxt);
        const char* nA = has_next ? (const char*)g.A + (size_t)nxt.pm * tstep : cA; const char* nB = has_next ? (const char*)g.Bt + (size_t)nxt.pn * tstep : cB;
        for (int t = 0; t < nt; t += 2) {
            const bool last = (t == nt - 2);
            const char* a1 = cA + (size_t)(t + 1) * kstep;
            const char* a2 = last ? nA : cA + (size_t)(t + 2) * kstep; const char* b2 = last ? nB : cB + (size_t)(t + 2) * kstep;
            const char* a3 = a2 + kstep; const char* b3 = b2 + kstep;
            if (last && has_next) S.a_ready(nxt);
            if constexpr (SP2) {
            PG8_LDB(B0, 0, 0); PG8_LDB(B1, 0, 1); PG8_SCHED; PG8_LDA(At, 0, 0); PG8_STAGE(PG8_SA(1, 1), a1 + hstep, voffA);
            PG8_WAIT_V(8); PG8_WAIT_L(0); PG8_BAR; PG8_MMA(0, 0, At, B0); PG8_MMA(0, 1, At, B1); PG8_BAR; PG8_SCHED;
            PG8_LDA(At, 0, 1); PG8_STAGE(PG8_SB(0, 0), b2, voffB); PG8_STAGE(PG8_SB(0, 1), b2 + hstep, voffB); PG8_STAGE(PG8_SA(0, 0), a2, voffA);
            PG8_WAIT_V(8); PG8_WAIT_L(0); PG8_BAR; PG8_MMA(1, 0, At, B0); PG8_MMA(1, 1, At, B1); PG8_BAR; PG8_SCHED;
            PG8_LDB(B0, 1, 0); PG8_LDB(B1, 1, 1); PG8_SCHED; PG8_LDA(At, 1, 0); PG8_STAGE(PG8_SA(0, 1), a2 + hstep, voffA);
            PG8_WAIT_V(8); PG8_WAIT_L(0); PG8_BAR; PG8_MMA(0, 0, At, B0); PG8_MMA(0, 1, At, B1); PG8_BAR; PG8_SCHED;
            PG8_LDA(At, 1, 1); PG8_STAGE(PG8_SB(1, 0), b3, voffB); PG8_STAGE(PG8_SB(1, 1), b3 + hstep, voffB); PG8_STAGE(PG8_SA(1, 0), a3, voffA);
            PG8_WAIT_V(8); PG8_WAIT_L(0); PG8_BAR; PG8_MMA(1, 0, At, B0); PG8_MMA(1, 1, At, B1); PG8_BAR; PG8_SCHED;
            } else {
            PG8_LDB(B0, 0, 0); PG8_SCHED; PG8_LDA(At, 0, 0); PG8_STAGE(PG8_SA(1, 1), a1 + hstep, voffA);
            PG8_WAIT_L(8); PG8_BAR; PG8_WAIT_L(0); PG8_MMA(0, 0, At, B0); PG8_BAR; PG8_SCHED;
            PG8_LDB(B1, 0, 1); PG8_STAGE(PG8_SB(0, 0), b2, voffB);
            PG8_BAR; PG8_WAIT_L(0); PG8_MMA(0, 1, At, B1); PG8_BAR;
            PG8_LDA(At, 0, 1); PG8_STAGE(PG8_SA(0, 0), a2, voffA);
            PG8_BAR; PG8_WAIT_L(0); PG8_MMA(1, 0, At, B0); PG8_BAR; PG8_SCHED;
            PG8_STAGE(PG8_SB(0, 1), b2 + hstep, voffB);
            PG8_WAIT_V(6); PG8_BAR; PG8_MMA(1, 1, At, B1); PG8_BAR;
            PG8_LDB(B0, 1, 0); PG8_SCHED; PG8_LDA(At, 1, 0); PG8_STAGE(PG8_SA(0, 1), a2 + hstep, voffA);
            PG8_WAIT_L(8); PG8_BAR; PG8_WAIT_L(0); PG8_MMA(0, 0, At, B0); PG8_BAR; PG8_SCHED;
            PG8_LDB(B1, 1, 1); PG8_STAGE(PG8_SB(1, 0), b3, voffB);
            PG8_BAR; PG8_WAIT_L(0); PG8_MMA(0, 1, At, B1); PG8_BAR;
            PG8_LDA(At, 1, 1); PG8_STAGE(PG8_SA(1, 0), a3, voffA);
            PG8_BAR; PG8_WAIT_L(0); PG8_MMA(1, 0, At, B0); PG8_BAR; PG8_SCHED;
            PG8_STAGE(PG8_SB(1, 1), b3 + hstep, voffB);
            PG8_WAIT_V(6); PG8_BAR; PG8_MMA(1, 1, At, B1); PG8_BAR;
            }
        }
        if constexpr (ALIGN_EPI) { if (wr == 0) PG8_BAR; }
        if constexpr (!Epi::AFTER_DRAIN) { E(acc, cur, wr, wc, fr, fq); S.done(cur); }
        if (!has_next) break;
#pragma unroll
        for (int a = 0; a < 2; ++a)
#pragma unroll
            for (int b = 0; b < 2; ++b)
#pragma unroll
                for (int m = 0; m < 4; ++m)
#pragma unroll
                    for (int n = 0; n < 2; ++n) acc[a][b][m][n] = (f32x4){0.f, 0.f, 0.f, 0.f};
        cur = nxt; cA = nA; cB = nB; ++ui;
        if constexpr (ALIGN_EPI) { if (wr == 1) PG8_BAR; }
    }
    PG8_WAIT_V(0);
    if constexpr (!ALIGN_EPI) { if (wr == 0) PG8_BAR; }
    PG8_BAR;
    if constexpr (Epi::AFTER_DRAIN) { E.fused(acc, cur, wr, wc, fr, fq, lds, wid, lane); S.done(cur); }
#undef PG8_SA
#undef PG8_SB
#undef PG8_STAGE
#undef PG8_LDA
#undef PG8_LDB
#undef PG8_MMA
#undef PG8_WAIT_V
#undef PG8_WAIT_L
#undef PG8_BAR
#undef PG8_SCHED
}
}

#ifndef MK_N_LAUNCHES
#define MK_N_LAUNCHES 1
#endif
constexpr int N_PHASES = 12;
#ifndef DUP_MASK
#define DUP_MASK 0
#endif
#define NREP(k) ((((DUP_MASK) >> (k)) & 1) ? 2 : 1)
constexpr int N_LAUNCHES = MK_N_LAUNCHES;
constexpr int NWAVES = 8;
constexpr int DM = 1024, NBATCH = 8, SEQ = 2048, TP = NBATCH * SEQ, NS = 128, TT = TP + NS;
constexpr int NPROJ = 3072;
constexpr int NIN = 3088;
constexpr int CH = 64, NCH = SEQ / CH, NBC = NBATCH * NCH;
constexpr float EPS = 1e-6f;
constexpr int POS_S = 16384;
constexpr int C_S5U = 0, C_S5Z = 256, C_HGQ = 512, C_HGF = 768, C_HGI = 1024, C_HGZ = 1280, C_GLQ = 1536, C_GLK = 1664, C_GLV = 1792, C_GLZ = 2048, C_RTQ = 2304, C_RTK = 2432, C_RTV = 2560, C_RTZ = 2816;
enum { I_XP = 0, I_XS, I_S5RE, I_S5IM, I_SHG, I_SGLA, I_SRET, I_NORMW, I_FNORMW, I_WIN, I_WOUT, I_LAMRE, I_LAMIM, I_LOGSTEP, I_BRE, I_BIM, I_CRE, I_CIM, I_S5D, I_WGLU, I_LBLOG, I_HGNW, I_GLWUP, I_GLB, I_GLNW, I_RTNW, N_INPUTS };
constexpr size_t O_YP = 0, O_YS = O_YP + (size_t)TP * DM, O_S5RE_P = O_YS + (size_t)NS * DM, O_S5IM_P = O_S5RE_P + 2 * 8 * 1024, O_HG_P = O_S5IM_P + 2 * 8 * 1024,
    O_GLA_P = O_HG_P + 2 * 8 * 16384, O_RET_P = O_GLA_P + 2 * 8 * 8192, O_S5RE_S = O_RET_P + 2 * 8 * 8192, O_S5IM_S = O_S5RE_S + 2 * 128 * 1024, O_HG_S = O_S5IM_S + 2 * 128 * 1024,
    O_GLA_S = O_HG_S + (size_t)2 * 128 * 16384, O_RET_S = O_GLA_S + (size_t)2 * 128 * 8192, O_END = O_RET_S + (size_t)2 * 128 * 8192;

constexpr size_t MiB = 1u << 20;
constexpr size_t WS_CTL = 0, CTL_ZERO_BYTES = 64 * 1024;
constexpr size_t WS_WIN = 2 * MiB;
constexpr size_t WS_WOUT = 14 * MiB;
constexpr size_t WS_WLR = 18 * MiB;
constexpr size_t WS_WGLU = WS_WLR + 64 * 1024;
constexpr size_t WS_BBT = WS_WGLU + 256 * 1024;
constexpr size_t WS_CCN = WS_BBT + 128 * 1024;
constexpr size_t WS_S5A = WS_CCN + 128 * 1024;
constexpr size_t WS_LB = WS_S5A + 32 * 1024;
constexpr size_t WS_ROT = WS_LB + 4 * 1024;
constexpr size_t WS_XB = 20 * MiB;
constexpr size_t WS_ROWSS = 53 * MiB;
constexpr size_t WS_ROWSS_S = WS_ROWSS + (size_t)TP * 16 * 4;
constexpr size_t WS_GG = 224 * MiB;
constexpr size_t WS_PROJ = 57 * MiB;
constexpr size_t WS_MIX = 154 * MiB;
constexpr size_t WS_SLOC = 187 * MiB;
constexpr size_t WS_DEC = 219 * MiB;
constexpr size_t WS_S5LOC = 220 * MiB;
constexpr size_t WS_APW = 233 * MiB;
constexpr size_t WS_BBF = 235 * MiB;
constexpr size_t WS_KTAB = 236 * MiB;
constexpr size_t WS_END = 238 * MiB;
static_assert(WS_ROT + 2 * 2048 * 16 * 4 + 256 <= WS_XB && WS_XB + (size_t)TT * DM * 2 <= WS_ROWSS && WS_ROWSS_S + 128 * 64 * 4 <= WS_PROJ, "ws map");
static_assert(WS_PROJ + (size_t)TT * NPROJ * 2 <= WS_MIX && WS_MIX + (size_t)TT * DM * 2 <= WS_SLOC && WS_SLOC + (size_t)NBC * 32768 * 4 <= WS_DEC && WS_DEC + (size_t)NBC * 512 * 4 <= WS_S5LOC && WS_S5LOC + (size_t)NBC * 2048 * 4 <= WS_GG && WS_GG + (size_t)TT * 128 * 4 <= WS_END, "ws map");
constexpr int CW_BAR = 4096;

constexpr int RING_BYTES = 131072;
constexpr int LDSCTL_OFF = RING_BYTES, MISC_OFF = LDSCTL_OFF + 320;
constexpr int LDS_BYTES = 147456;

#define LAS __attribute__((address_space(3)))
typedef unsigned short bf16;
typedef short bf16x8 __attribute__((ext_vector_type(8)));
typedef short bf16x4 __attribute__((ext_vector_type(4)));
typedef float f32x4 __attribute__((ext_vector_type(4)));
typedef float f32x2 __attribute__((ext_vector_type(2)));
typedef float f32x16 __attribute__((ext_vector_type(16)));
typedef unsigned u32x4 __attribute__((ext_vector_type(4)));
typedef unsigned u32x2 __attribute__((ext_vector_type(2)));
#define RLX_AGENT __ATOMIC_RELAXED, __HIP_MEMORY_SCOPE_AGENT
#define LDS_WAIT() asm volatile("s_waitcnt lgkmcnt(0)" ::: "memory")
#define VM_WAIT() asm volatile("s_waitcnt vmcnt(0)" ::: "memory")

__device__ __forceinline__ void bsync() { __builtin_amdgcn_fence(__ATOMIC_RELEASE, "workgroup"); __builtin_amdgcn_s_barrier(); __builtin_amdgcn_fence(__ATOMIC_ACQUIRE, "workgroup"); }
__device__ __forceinline__ unsigned f2bf(float f) { unsigned u = __builtin_bit_cast(unsigned, f); return (u + 0x7fffu + ((u >> 16) & 1u)) >> 16; }
__device__ __forceinline__ unsigned pk2(float lo, float hi) { return f2bf(lo) | (f2bf(hi) << 16); }
__device__ __forceinline__ float bf2f(short b) { return __builtin_bit_cast(float, ((unsigned)(unsigned short)b) << 16); }
__device__ __forceinline__ u32x4 pack8(const float* v) { u32x4 w; w.x = pk2(v[0], v[1]); w.y = pk2(v[2], v[3]); w.z = pk2(v[4], v[5]); w.w = pk2(v[6], v[7]); return w; }
__device__ __forceinline__ float rcpf_(float x) { return __builtin_amdgcn_rcpf(x); }
__device__ __forceinline__ float sigmoidf_(float x) { return rcpf_(1.0f + __expf(-x)); }
__device__ __forceinline__ float siluf_(float x) { return x * rcpf_(1.0f + __expf(-x)); }
__device__ __forceinline__ float logsigmoidf_(float x) { return fminf(x, 0.f) - __logf(1.0f + __expf(-fabsf(x))); }
__device__ __forceinline__ float gelu_tanh(float x) { const float u = 0.7978845608028654f * (x + 0.044715f * x * x * x); return x * rcpf_(1.0f + __expf(-2.0f * u)); }
__device__ __forceinline__ float wave_sum(float v) {
#pragma unroll
    for (int o = 1; o < 64; o <<= 1) v += __shfl_xor(v, o);
    return v;
}

#define XB_TMO      128
#define XB_XCNT(j)  (256  + 64 * (j))
#define XB_XSUB(j)  (1280 + 64 * (j))
#define XB_XGEN(j)  (2304 + 64 * (j))
#define XB_TOP      3328
#define XB_TOPGEN   3392
#define XCD_BAR_WORDS 3456
#define XB_SPIN_CAP (1u << 18)
__device__ __forceinline__ unsigned xb_ld(unsigned* p)              { return __hip_atomic_load(p, __ATOMIC_RELAXED, __HIP_MEMORY_SCOPE_AGENT); }
__device__ __forceinline__ unsigned xb_add(unsigned* p, unsigned v) { return __hip_atomic_fetch_add(p, v, __ATOMIC_RELAXED, __HIP_MEMORY_SCOPE_AGENT); }
__device__ __forceinline__ unsigned xb_xcc_id() { return (unsigned)__builtin_amdgcn_s_getreg((3 << 11) | 20) & 0xFu; }
#define XB_SPIN(cond, bar) do { unsigned _sp = 0; while (cond) { __builtin_amdgcn_s_sleep(1); \
    if ((++_sp & 255u) == 0u) { if (xb_ld(&(bar)[XB_TMO])) break; if (_sp > XB_SPIN_CAP) { atomicAdd(&(bar)[XB_TMO], 1u); break; } } } } while (0)
struct XcdBarrier { unsigned* bar; unsigned x; volatile LAS unsigned* st; };
__device__ __forceinline__ XcdBarrier xcd_barrier_post(unsigned* bar, volatile LAS unsigned* st) {
    XcdBarrier b; b.bar = bar; b.x = xb_xcc_id(); b.st = st;
    if (threadIdx.x == 0) (void)xb_add(&bar[XB_XCNT(b.x)], 1u);
    return b;
}
__device__ __forceinline__ void xcd_barrier_complete(unsigned* bar, unsigned x, unsigned& nloc, unsigned& nx) {
    const unsigned G = gridDim.x * gridDim.y * gridDim.z;
    unsigned sum, cnt, mine, sp = 0u;
    for (;;) {
        sum = 0u; cnt = 0u; mine = 0u;
#pragma unroll
        for (unsigned j = 0; j < 16; ++j) { const unsigned c = xb_ld(&bar[XB_XCNT(j)]); sum += c; cnt += (c > 0u) ? 1u : 0u; mine = (j == x) ? c : mine; }
        if (sum == G) break;
        __builtin_amdgcn_s_sleep(1);
        if ((++sp & 255u) == 0u) { if (xb_ld(&bar[XB_TMO])) break; if (sp > XB_SPIN_CAP) { atomicAdd(&bar[XB_TMO], 1u); break; } }
    }
    nloc = mine > 0u ? mine : 1u; nx = cnt > 0u ? cnt : 1u;
}
__device__ __forceinline__ void xcd_barrier(const XcdBarrier& b) {
    asm volatile("s_waitcnt vmcnt(0)" ::: "memory");
    bsync();
    if (threadIdx.x == 0) {
        unsigned* bar = b.bar;
        __builtin_amdgcn_s_waitcnt(0);
        unsigned nloc = b.st[0], nx = b.st[1];
        if (nloc == 0u) { xcd_barrier_complete(bar, b.x, nloc, nx); b.st[0] = nloc; b.st[1] = nx; }
        const unsigned old = xb_add(&bar[XB_XSUB(b.x)], 1u);
        const unsigned gen = old / nloc;
        if (old + 1u == (gen + 1u) * nloc) {
            __builtin_amdgcn_fence(__ATOMIC_RELEASE, "agent");
            asm volatile("s_waitcnt vmcnt(0)" ::: "memory");
            const unsigned og = xb_add(&bar[XB_TOP], 1u);
            const unsigned tg = og / nx;
            if (og + 1u == (tg + 1u) * nx) xb_add(&bar[XB_TOPGEN], 1u);
            else XB_SPIN(xb_ld(&bar[XB_TOPGEN]) == tg, bar);
            __builtin_amdgcn_fence(__ATOMIC_ACQUIRE, "agent");
            xb_add(&bar[XB_XGEN(b.x)], 1u);
            asm volatile("s_waitcnt vmcnt(0)" ::: "memory");
        } else {
            XB_SPIN(xb_ld(&bar[XB_XGEN(b.x)]) == gen, bar);
            __builtin_amdgcn_fence(__ATOMIC_ACQUIRE, "agent");
            asm volatile("s_waitcnt vmcnt(0)" ::: "memory");
        }
    }
    bsync();
}

struct Args { const float* in[N_INPUTS]; float* out; unsigned char* ws; int ph_lo, ph_hi, li, pad; };
#define KARG (F.kp)
#define INP(i) ((const float*)KARG->in[i])
#define OUTP ((float*)KARG->out)
#define WSP ((unsigned char*)KARG->ws)
#define P_WIN ((bf16*)(WSP + WS_WIN))
#define P_WOUT ((bf16*)(WSP + WS_WOUT))
#define P_WLR ((bf16*)(WSP + WS_WLR))
#define P_WGLU ((bf16*)(WSP + WS_WGLU))
#define P_BBT ((bf16*)(WSP + WS_BBT))
#define P_CCN ((bf16*)(WSP + WS_CCN))
#define P_APW ((float*)(WSP + WS_APW))
#define P_BBF ((float*)(WSP + WS_BBF))
#define P_KTAB ((bf16*)(WSP + WS_KTAB))
#define P_XB ((bf16*)(WSP + WS_XB))
#define P_PROJ ((bf16*)(WSP + WS_PROJ))
#define P_MIX ((bf16*)(WSP + WS_MIX))
#define P_S5A ((float*)(WSP + WS_S5A))
#define P_LB ((float*)(WSP + WS_LB))
#define P_ROT ((float*)(WSP + WS_ROT))
#define P_ROWSS ((float*)(WSP + WS_ROWSS))
#define P_ROWSS_S ((float*)(WSP + WS_ROWSS_S))
#define P_GG ((float*)(WSP + WS_GG))
#define P_SLOC ((float*)(WSP + WS_SLOC))
#define P_DEC ((float*)(WSP + WS_DEC))
#define P_S5LOC ((float*)(WSP + WS_S5LOC))
typedef const __attribute__((address_space(4))) Args* KargPtr;
struct Frame { LAS unsigned char* lds; int tid, lane, wave, G, bid; KargPtr kp; };
__device__ __forceinline__ Frame fresh(const Frame& F0) {
    Frame R; R.lds = F0.lds; int t = F0.tid; asm volatile("" : "+v"(t)); R.tid = t; R.lane = t & 63; R.wave = __builtin_amdgcn_readfirstlane(t >> 6);
    int g = F0.G, b = F0.bid; asm volatile("" : "+s"(g), "+s"(b)); R.G = g; R.bid = b;
    KargPtr p = F0.kp; asm volatile("" : "+s"(p)); R.kp = p; return R;
}

namespace pg8 {
struct EpiProj {
    static constexpr bool PERM = true, AFTER_DRAIN = false;
    bf16_t* O; const float* rowss;
    __device__ __forceinline__ void operator()(const f32x4 (&acc)[2][2][4][2], const Unit& u, int wr, int wc, int fr, int fq) const {
        const int row0 = u.pm * BM + wr * 64 + fr, col0 = u.pn * BM + wc * 32 + 8 * fq;
#pragma unroll
        for (int ai = 0; ai < 2; ++ai)
#pragma unroll
            for (int m = 0; m < 4; ++m) {
                const int row = row0 + ai * HALF + m * 16;
                const f32x4* rp = (const f32x4*)(rowss + (size_t)row * 16);
                const f32x4 p0 = rp[0], p1 = rp[1], p2 = rp[2], p3 = rp[3];
                const float ss = ((p0[0] + p0[1]) + (p0[2] + p0[3])) + ((p1[0] + p1[1]) + (p1[2] + p1[3])) + ((p2[0] + p2[1]) + (p2[2] + p2[3])) + ((p3[0] + p3[1]) + (p3[2] + p3[3]));
                const float rstd = 1.0f / sqrtf(ss * (1.0f / 1024.0f) + 1e-6f);
                bf16_t* rowp = O + (size_t)row * 3072 + col0;
#pragma unroll
                for (int bj = 0; bj < 2; ++bj) { const f32x4 v0 = acc[ai][bj][m][0] * rstd, v1 = acc[ai][bj][m][1] * rstd;
                    u32x4 w; w.x = cvt_pk_bf16(v0[0], v0[1]); w.y = cvt_pk_bf16(v0[2], v0[3]); w.z = cvt_pk_bf16(v1[0], v1[1]); w.w = cvt_pk_bf16(v1[2], v1[3]);
                    *(u32x4*)(rowp + bj * HALF) = w; }
            }
    }
};
struct EpiRes {
    static constexpr bool PERM = false, AFTER_DRAIN = false;
    const float* base; float* xo; bf16_t* xb; float* rowss;
    __device__ __forceinline__ void operator()(const f32x4 (&acc)[2][2][4][2], const Unit& u, int wr, int wc, int fr, int fq) const {
        const int row0 = u.pm * BM + wr * 64 + fr, col0 = u.pn * BM + wc * 32 + 4 * fq;
#pragma unroll
        for (int ai = 0; ai < 2; ++ai)
#pragma unroll
            for (int m = 0; m < 4; ++m) {
                const int row = row0 + ai * HALF + m * 16; const size_t off = (size_t)row * 1024 + col0; float ss = 0.f;
#pragma unroll
                for (int bj = 0; bj < 2; ++bj)
#pragma unroll
                    for (int n = 0; n < 2; ++n) { const f32x4 bs = *(const f32x4*)(base + off + bj * HALF + n * 16); const f32x4 o = bs + acc[ai][bj][m][n];
                        *(f32x4*)(xo + off + bj * HALF + n * 16) = o; ss += (o[0] * o[0] + o[1] * o[1]) + (o[2] * o[2] + o[3] * o[3]);
                        if (xb) { typedef unsigned u32x2v __attribute__((ext_vector_type(2))); u32x2v w; w.x = cvt_pk_bf16(o[0], o[1]); w.y = cvt_pk_bf16(o[2], o[3]); *(u32x2v*)(xb + off + bj * HALF + n * 16) = w; } }
                ss += __shfl_xor(ss, 16); ss += __shfl_xor(ss, 32);
                if (fq == 0) rowss[(size_t)row * 16 + u.pn * 4 + wc] = ss;
                asm volatile("" ::: "memory");
            }
    }
};
}

__device__ __forceinline__ f32x4 tile16(const LAS bf16* A, int lda, const LAS bf16* Bt, int ldb, int K, int lane) {
    const LAS bf16* ap = A + (lane & 15) * lda + 8 * (lane >> 4);
    const LAS bf16* bp = Bt + (lane & 15) * ldb + 8 * (lane >> 4);
    f32x4 acc = {0.f, 0.f, 0.f, 0.f};
    for (int k0 = 0; k0 < K; k0 += 32) {
        const bf16x8 a = *(const LAS bf16x8*)(ap + k0), b = *(const LAS bf16x8*)(bp + k0);
        acc = __builtin_amdgcn_mfma_f32_16x16x32_bf16(a, b, acc, 0, 0, 0);
    }
    return acc;
}

template <int NT>
__device__ __forceinline__ void small_unit(const bf16* A, const bf16* Bt, int wave, int lane, f32x4 (&acc)[NT]) {
    static_assert(NT == 1, "one 16-column tile per wave");
    const bf16* ap = A + (size_t)(16 * wave + (lane & 15)) * 1024 + 8 * (lane >> 4);
    const bf16* bp = Bt + (size_t)(lane & 15) * 1024 + 8 * (lane >> 4);
    acc[0] = (f32x4){0.f, 0.f, 0.f, 0.f};
    bf16x8 a0[8], b0[8], a1[8], b1[8];
#pragma unroll
    for (int i = 0; i < 8; ++i) { a0[i] = *(const bf16x8*)(ap + 32 * i); b0[i] = *(const bf16x8*)(bp + 32 * i); }
#pragma unroll
    for (int i = 0; i < 8; ++i) { a1[i] = *(const bf16x8*)(ap + 32 * (8 + i)); b1[i] = *(const bf16x8*)(bp + 32 * (8 + i)); }
#pragma unroll
    for (int i = 0; i < 8; ++i) acc[0] = __builtin_amdgcn_mfma_f32_16x16x32_bf16(b0[i], a0[i], acc[0], 0, 0, 0);
#pragma unroll
    for (int i = 0; i < 8; ++i) { a0[i] = *(const bf16x8*)(ap + 32 * (16 + i)); b0[i] = *(const bf16x8*)(bp + 32 * (16 + i)); }
#pragma unroll
    for (int i = 0; i < 8; ++i) acc[0] = __builtin_amdgcn_mfma_f32_16x16x32_bf16(b1[i], a1[i], acc[0], 0, 0, 0);
#pragma unroll
    for (int i = 0; i < 8; ++i) { a1[i] = *(const bf16x8*)(ap + 32 * (24 + i)); b1[i] = *(const bf16x8*)(bp + 32 * (24 + i)); }
#pragma unroll
    for (int i = 0; i < 8; ++i) acc[0] = __builtin_amdgcn_mfma_f32_16x16x32_bf16(b0[i], a0[i], acc[0], 0, 0, 0);
#pragma unroll
    for (int i = 0; i < 8; ++i) acc[0] = __builtin_amdgcn_mfma_f32_16x16x32_bf16(b1[i], a1[i], acc[0], 0, 0, 0);
}

__device__ __forceinline__ void p0_transpose_item(const float* W, int ldw, int k0, int nsrc0, const float* ks, bf16* WT, int ldt, int ndst0, int nkeep, LAS float* scr, int lane) {
#pragma unroll 8
    for (int i = 0; i < 32; ++i) { const int kk = 2 * i + (lane >> 5); float v = W[(size_t)(k0 + kk) * ldw + nsrc0 + (lane & 31)]; if (ks) v *= ks[k0 + kk]; scr[kk * 33 + (lane & 31)] = v; }
    LDS_WAIT();
    const int c = lane & 7;
#pragma unroll
    for (int j = 0; j < 4; ++j) { const int n = (lane >> 3) + 8 * j; const LAS float* s = scr + (8 * c) * 33 + n;
        u32x4 o; o.x = pk2(s[0 * 33], s[1 * 33]); o.y = pk2(s[2 * 33], s[3 * 33]); o.z = pk2(s[4 * 33], s[5 * 33]); o.w = pk2(s[6 * 33], s[7 * 33]);
        if (n < nkeep) *(u32x4*)(WT + (size_t)(ndst0 + n) * ldt + k0 + 8 * c) = o; }
    LDS_WAIT();
}

__device__ __forceinline__ void p0_prologue(const Frame& F0, int parts) {
    const Frame F = fresh(F0);
    LAS float* scr = (LAS float*)(F.lds + F.wave * 16384);
    const int gw = F.bid * NWAVES + F.wave, NGW = F.G * NWAVES, lane = F.lane;
    constexpr int I_IN = 16 * 96, I_LRI = 16, I_OUT = 16 * 32, I_GLU = 4 * 8, PER_L = I_IN + I_LRI + I_OUT + I_GLU;
    if (parts & 1)
    for (int it = gw; it < 2 * PER_L; it += NGW) {
        const int l = it / PER_L; int r = it % PER_L;
        const float* win = INP(I_WIN) + (size_t)l * 1024 * NIN; const float* nw = INP(I_NORMW) + l * 1024;
        if (r < I_IN) { const int kb = r / 96, nb = r % 96, n0 = 32 * nb, ns = n0 < 2048 ? n0 : n0 + 16;
            p0_transpose_item(win, NIN, 64 * kb, ns, nw, P_WIN + (size_t)l * NPROJ * 1024, 1024, n0, 32, scr, lane); continue; } r -= I_IN;
        if (r < I_LRI) { p0_transpose_item(win, NIN, 64 * r, 2048, nw, P_WLR + (size_t)l * 16 * 1024, 1024, 0, 16, scr, lane); continue; } r -= I_LRI;
        if (r < I_OUT) { const int kb = r / 32, nb = r % 32;
            p0_transpose_item(INP(I_WOUT) + (size_t)l * 1024 * 1024, 1024, 64 * kb, 32 * nb, nullptr, P_WOUT + (size_t)l * 1024 * 1024, 1024, 32 * nb, 32, scr, lane); continue; } r -= I_OUT;
        { const int kb = r / 8, nb = r % 8;
            p0_transpose_item(INP(I_WGLU) + (size_t)l * 256 * 256, 256, 64 * kb, 32 * nb, nullptr, P_WGLU + (size_t)l * 256 * 256, 256, 32 * nb, 32, scr, lane); }
    }
    if (parts & 2)
    for (int m = gw; m < TT; m += NGW) {
        const float* xrow = m < TP ? INP(I_XP) + (size_t)m * DM : INP(I_XS) + (size_t)(m - TP) * DM;
        const f32x4* xr = (const f32x4*)xrow + lane;
        f32x4 v[4]; float s = 0.f;
#pragma unroll
        for (int j = 0; j < 4; ++j) { v[j] = xr[64 * j]; s += (v[j][0] * v[j][0] + v[j][1] * v[j][1]) + (v[j][2] * v[j][2] + v[j][3] * v[j][3]); }
        s = wave_sum(s);
        u32x2* o8 = (u32x2*)(P_XB + (size_t)m * DM) + lane;
#pragma unroll
        for (int j = 0; j < 4; ++j) { u32x2 w; w.x = pk2(v[j][0], v[j][1]); w.y = pk2(v[j][2], v[j][3]); o8[64 * j] = w; }
        if (m < TP) { if (lane < 16) P_ROWSS[(size_t)m * 16 + lane] = lane == 0 ? s : 0.f; }
        else { P_ROWSS_S[(size_t)(m - TP) * 64 + lane] = lane == 0 ? s : 0.f; }
    }
    const int gt = F.bid * 512 + F.tid, NGT = F.G * 512;
    if (parts & 4)
    for (int i = gt; i < 2 * 16 * 64; i += NGT) {
        const int l = i >> 10, g = (i >> 6) & 15, p = i & 63;
        const float lr = INP(I_LAMRE)[i], li = INP(I_LAMIM)[i], step = expf(INP(I_LOGSTEP)[l * 16 + g]);
        const float mag = expf(lr * step), are = mag * cosf(li * step), aim = mag * sinf(li * step);
        const float den = lr * lr + li * li, nr = are - 1.0f;
        const float fre = (nr * lr + aim * li) / den, fim = (aim * lr - nr * li) / den;
        const float m64 = expf(lr * step * 64.f), a64r = m64 * cosf(li * step * 64.f), a64i = m64 * sinf(li * step * 64.f);
        float* sa = P_S5A + (size_t)i * 4; sa[0] = are; sa[1] = aim; sa[2] = a64r; sa[3] = a64i;
        const float* bre = INP(I_BRE) + (size_t)i * 16; const float* bim = INP(I_BIM) + (size_t)i * 16;
        bf16* bb = P_BBT + (size_t)(l * 16 + g) * 128 * 16;
        for (int c = 0; c < 16; ++c) { const float br = bre[c], bi = bim[c];
            bb[(p) * 16 + c] = (bf16)f2bf(fre * br - fim * bi); bb[(64 + p) * 16 + c] = (bf16)f2bf(fre * bi + fim * br);
 }
        const float* cre = INP(I_CRE) + (size_t)(l * 16 + g) * 16 * 64; const float* cim = INP(I_CIM) + (size_t)(l * 16 + g) * 16 * 64;
        bf16* cc = P_CCN + (size_t)(l * 16 + g) * 16 * 128;
        for (int c = 0; c < 16; ++c) { cc[c * 128 + 2 * p] = (bf16)f2bf(cre[c * 64 + p]); cc[c * 128 + 2 * p + 1] = (bf16)f2bf(-cim[c * 64 + p]); }
    }
    if (parts & 4)
    for (int i = gt; i < 256; i += NGT) { const float l0 = INP(I_LBLOG)[i], l1 = INP(I_LBLOG)[256 + i]; P_LB[i] = 0.f; P_LB[256 + i] = 1.0f / (1.0f + expf(l0 - l1)); }
    if (parts & 4)
    for (int i = gt; i < 2049 * 16; i += NGT) { const int pos = i >> 4, j = i & 15; const float inv = powf(10000.0f, -(float)j / 16.0f);
        const float ang = (pos < 2048 ? (float)pos : (float)POS_S) * inv; P_ROT[i] = cosf(ang); P_ROT[2049 * 16 + i] = sinf(ang); }
}

__device__ __forceinline__ float rstd_prompt(const Frame& F, int row) {
    const f32x4* rp = (const f32x4*)(P_ROWSS + (size_t)row * 16); const f32x4 p0 = rp[0], p1 = rp[1], p2 = rp[2], p3 = rp[3];
    const float ss = ((p0[0] + p0[1]) + (p0[2] + p0[3])) + ((p1[0] + p1[1]) + (p1[2] + p1[3])) + ((p2[0] + p2[1]) + (p2[2] + p2[3])) + ((p3[0] + p3[1]) + (p3[2] + p3[3]));
    return 1.0f / sqrtf(ss * (1.0f / 1024.0f) + EPS);
}
__device__ __forceinline__ float rstd_sample(const Frame& F, int srow) {
    const f32x4* rp = (const f32x4*)(P_ROWSS_S + (size_t)srow * 64); float ss = 0.f;
#pragma unroll
    for (int i = 0; i < 16; ++i) { const f32x4 p = rp[i]; ss += (p[0] + p[1]) + (p[2] + p[3]); }
    return 1.0f / sqrtf(ss * (1.0f / 1024.0f) + EPS);
}
__device__ __forceinline__ void gate_rows(const Frame& F, int l, int row, f32x4 lr4, int lane) {
    const int r = lane & 15, q = lane >> 4;
    float lrv[16];
#pragma unroll
    for (int qq = 0; qq < 4; ++qq)
#pragma unroll
        for (int rr = 0; rr < 4; ++rr) lrv[4 * qq + rr] = __shfl(lr4[rr], r + 16 * qq);
    const float* wup = INP(I_GLWUP) + (size_t)l * 16 * 128 + 32 * q; const float* bg = INP(I_GLB) + l * 128 + 32 * q;
    float* gout = P_GG + (size_t)row * 128 + 32 * q;
#pragma unroll 2
    for (int jc = 0; jc < 8; ++jc) { f32x4 a4 = *(const f32x4*)(bg + 4 * jc);
#pragma unroll
        for (int rr = 0; rr < 16; ++rr) a4 += *(const f32x4*)(wup + rr * 128 + 4 * jc) * lrv[rr];
        f32x4 g4;
#pragma unroll
        for (int j = 0; j < 4; ++j) g4[j] = logsigmoidf_(a4[j]) * (1.0f / 16.0f);
        *(f32x4*)(gout + 4 * jc) = g4; }
}
__device__ __forceinline__ void p2_chunk_gates(const Frame& F0, int l, int b, int ch) {
    const Frame F = fresh(F0);
    const int wave = F.wave, lane = F.lane, kh = wave >> 2, rt = wave & 3;
    const size_t row = (size_t)b * SEQ + (size_t)ch * CH + 16 * rt + (lane & 15);
    const bf16* ap = P_XB + row * 1024 + 512 * kh + 8 * (lane >> 4);
    const bf16* bp = P_WLR + (size_t)l * 16 * 1024 + (size_t)(lane & 15) * 1024 + 512 * kh + 8 * (lane >> 4);
    f32x4 acc = {0.f, 0.f, 0.f, 0.f};
    bf16x8 av[16], bv[16];
#pragma unroll
    for (int ks = 0; ks < 16; ++ks) { av[ks] = *(const bf16x8*)(ap + 32 * ks); bv[ks] = *(const bf16x8*)(bp + 32 * ks); }
#pragma unroll
    for (int ks = 0; ks < 16; ++ks) acc = __builtin_amdgcn_mfma_f32_16x16x32_bf16(bv[ks], av[ks], acc, 0, 0, 0);
    LAS f32x4* PG = (LAS f32x4*)F.lds;
    bsync();
    if (kh == 1) PG[rt * 64 + lane] = acc;
    bsync();
    if (kh == 0) { acc += PG[rt * 64 + lane]; gate_rows(F, l, (int)row, acc * rstd_prompt(F, (int)row), lane); }
}
constexpr int N_G1_SMALL = 193;
__device__ __forceinline__ void g1_small_unit(const Frame& F0, int l, int u) {
    const Frame F = fresh(F0);
    const int wave = F.wave, lane = F.lane, r = lane & 15, q = lane >> 4;
    const int srow = 16 * wave + r; const float rs = rstd_sample(F, srow);
    f32x4 acc[1];
    if (u == 192) {
        small_unit<1>(P_XB + (size_t)TP * 1024, P_WLR + (size_t)l * 16 * 1024, wave, lane, acc);
        gate_rows(F, l, TP + srow, acc[0] * rs, lane);
    } else {
        const int c0 = u * 16;
        small_unit<1>(P_XB + (size_t)TP * 1024, P_WIN + (size_t)l * NPROJ * 1024 + (size_t)c0 * 1024, wave, lane, acc);
        const f32x4 v = acc[0] * rs; u32x2 w; w.x = pk2(v[0], v[1]); w.y = pk2(v[2], v[3]);
        *(u32x2*)(P_PROJ + (size_t)(TP + srow) * NPROJ + c0 + 4 * q) = w;
    }
}
constexpr int N_G2_SMALL = 64;
__device__ __forceinline__ void g2_small_unit(const Frame& F0, int l, int u) {
    const Frame F = fresh(F0);
    const int wave = F.wave, lane = F.lane, r = lane & 15, q = lane >> 4, c = u * 16 + 4 * q;
    f32x4 acc[1];
    small_unit<1>(P_MIX + (size_t)TP * 1024, P_WOUT + (size_t)l * 1024 * 1024 + (size_t)(u * 16) * 1024, wave, lane, acc);
    const int srow = 16 * wave + r;
    const float* base = (l == 0 ? INP(I_XS) : OUTP + O_YS) + (size_t)srow * 1024;
    float* xo = OUTP + O_YS + (size_t)srow * 1024;
    const f32x4 o = *(const f32x4*)(base + c) + acc[0];
    *(f32x4*)(xo + c) = o; float ss = (o[0] * o[0] + o[1] * o[1]) + (o[2] * o[2] + o[3] * o[3]);
    if (l == 0) { u32x2 w; w.x = pk2(o[0], o[1]); w.y = pk2(o[2], o[3]); *(u32x2*)(P_XB + (size_t)(TP + srow) * 1024 + c) = w; }
    ss += __shfl_xor(ss, 16); ss += __shfl_xor(ss, 32);
    if (q == 0) P_ROWSS_S[(size_t)srow * 64 + u] = ss;
}

__device__ __forceinline__ f32x4 tile16T(const LAS bf16* A, int lda, const LAS bf16* Bt, int ldb, int K, int lane) {
    const LAS bf16* ap = A + (lane & 15) * lda + 8 * (lane >> 4);
    const LAS bf16* bp = Bt + (lane & 15) * ldb + 8 * (lane >> 4);
    f32x4 acc = {0.f, 0.f, 0.f, 0.f};
    for (int k0 = 0; k0 < K; k0 += 32) {
        const bf16x8 a = *(const LAS bf16x8*)(ap + k0), b = *(const LAS bf16x8*)(bp + k0);
        acc = __builtin_amdgcn_mfma_f32_16x16x32_bf16(b, a, acc, 0, 0, 0);
    }
    return acc;
}
struct AttPre { bf16x8 q8, k8, qp8, kp8, vv; f32x4 g0, g1, rc0, rc1, rs0, rs1, sp4[2]; bf16x4 z4[2]; };
template <int BR, int PH>
__device__ __forceinline__ void att_prefetch(const Frame& F0, int l, int b, int ch, int h, AttPre& P) {
    const Frame F = fresh(F0);
    constexpr int DK = (BR == 0) ? 64 : 32, NG = DK / 8;
    constexpr int QOFF = BR == 0 ? C_HGQ : (BR == 1 ? C_GLQ : C_RTQ), KOFF = BR == 0 ? C_HGF : (BR == 1 ? C_GLK : C_RTK), VOFF = BR == 0 ? C_HGI : (BR == 1 ? C_GLV : C_RTV), ZOFF = BR == 0 ? C_HGZ : (BR == 1 ? C_GLZ : C_RTZ);
    constexpr int SOFF = BR == 0 ? 0 : (BR == 1 ? 16384 : 24576);
    const int tid = F.tid, lane = F.lane, wave = F.wave;
    const size_t row0 = (size_t)b * SEQ + (size_t)ch * CH;
    const bf16* proj = P_PROJ;
    const bool act = tid < 64 * NG;
    const int t = tid / NG, kg = tid % NG, tv = tid >> 3, vg = tid & 7;
    if (act) {
        const bf16* pr = proj + (row0 + t) * NPROJ;
        if (PH == 4) P.q8 = *(const bf16x8*)(pr + QOFF + h * DK + 8 * kg);
        P.k8 = *(const bf16x8*)(pr + KOFF + h * DK + 8 * kg);
        if (BR == 1) { const f32x4* gp = (const f32x4*)(P_GG + (row0 + t) * 128 + h * 32 + 8 * kg); P.g0 = gp[0]; P.g1 = gp[1]; }
        if (BR == 2) { if (PH == 4) P.qp8 = *(const bf16x8*)(pr + QOFF + h * 32 + 8 * (kg ^ 2)); P.kp8 = *(const bf16x8*)(pr + KOFF + h * 32 + 8 * (kg ^ 2));
            const int pos = ch * CH + t; const f32x4* rc = (const f32x4*)(P_ROT + (size_t)pos * 16 + 8 * (kg & 1)); const f32x4* rsn = (const f32x4*)(P_ROT + 2049 * 16 + (size_t)pos * 16 + 8 * (kg & 1));
            P.rc0 = rc[0]; P.rc1 = rc[1]; P.rs0 = rsn[0]; P.rs1 = rsn[1]; }
    }
    P.vv = *(const bf16x8*)(proj + (row0 + tv) * NPROJ + VOFF + h * 64 + 8 * vg);
    if (PH == 4) {
        const float* sl = P_SLOC + ((size_t)(b * NCH + ch) * 32768 + SOFF + (size_t)h * DK * 64);
        constexpr int NSP = DK * 64 / 4 / 512;
#pragma unroll
        for (int n = 0; n < NSP; ++n) P.sp4[n] = *(const f32x4*)(sl + 4 * (tid + 512 * n));
        const int ti = wave >> 1, vj0 = 2 * (wave & 1), fr = lane & 15, fq = lane >> 4;
#pragma unroll
        for (int e = 0; e < 2; ++e) P.z4[e] = *(const bf16x4*)(proj + (row0 + 16 * ti + fr) * NPROJ + ZOFF + h * 64 + 16 * (vj0 + e) + 4 * fq);
    }
}
template <int BR, int PH>
__device__ __forceinline__ void att_item(const Frame& F0, int l, int b, int ch, int h, const AttPre& P) {
    const Frame F = fresh(F0);
    constexpr int DK = (BR == 0) ? 64 : 32, NG = DK / 8, KS = DK + 64, NWV = DK / 8, RPW = 64 / NWV;
    constexpr int SOFF = BR == 0 ? 0 : (BR == 1 ? 16384 : 24576), DOFF = BR == 0 ? 0 : (BR == 1 ? 256 : 384);
    LAS unsigned char* L = F.lds;
    LAS float* WT = (LAS float*)(L + 0);
    LAS float* PART = (LAS float*)(L + 2048);
    LAS bf16* A1 = (LAS bf16*)(L + 4096);
    LAS bf16* B1 = (LAS bf16*)(L + 21504);
    LAS bf16* QH = (LAS bf16*)(L + 38912);
    LAS bf16* KH = (LAS bf16*)(L + 48128);
    LAS bf16* KT = (LAS bf16*)(L + 71168);
    LAS bf16* VT = (LAS bf16*)(L + 80384);
    const int tid = F.tid, lane = F.lane, wave = F.wave;
    const size_t row0 = (size_t)b * SEQ + (size_t)ch * CH;
    const bool act = tid < 64 * NG;
    const int t = tid / NG, kg = tid % NG;
    const int tv = tid >> 3, vg = tid & 7;
    const bf16x8 q8 = P.q8, k8 = P.k8, qp8 = P.qp8, kp8 = P.kp8, vv = P.vv; const f32x4 g0 = P.g0, g1 = P.g1, rc0 = P.rc0, rc1 = P.rc1, rs0 = P.rs0, rs1 = P.rs1;
    f32x4 lb0 = {}, lb1 = {};
    if (BR == 0 && act) { const f32x4* lbp = (const f32x4*)(P_LB + l * 256 + h * 64 + 8 * kg); lb0 = lbp[0]; lb1 = lbp[1]; }
    float* sl = P_SLOC + ((size_t)(b * NCH + ch) * 32768 + SOFF + (size_t)h * DK * 64);
    constexpr int NSP = DK * 64 / 4 / 512;
    const int ti = wave >> 1, vj0 = 2 * (wave & 1), fr = lane & 15, fq = lane >> 4;
    f32x4 nw4[2] = {};
    if (PH == 4) { const float* nw = INP(BR == 0 ? I_HGNW : (BR == 1 ? I_GLNW : I_RTNW)) + l * 256 + h * 64;
#pragma unroll
        for (int e = 0; e < 2; ++e) nw4[e] = *(const f32x4*)(nw + 16 * (vj0 + e) + 4 * fq); }
    float qv[8], kv[8], bt[8];
    if (act) {
        if (BR == 0) { const float lbv[8] = {lb0[0], lb0[1], lb0[2], lb0[3], lb1[0], lb1[1], lb1[2], lb1[3]};
#pragma unroll
            for (int j = 0; j < 8; ++j) { const float x = bf2f(k8[j]), lb = lbv[j], e = __expf(-x), sg = rcpf_(1.0f + e), f = lb + (1.0f - lb) * sg;
                bt[j] = fmaxf(__logf(f), -60.f); kv[j] = (1.0f - lb) * e * sg; qv[j] = bf2f(q8[j]); }
        } else if (BR == 1) { const float gg[8] = {g0[0], g0[1], g0[2], g0[3], g1[0], g1[1], g1[2], g1[3]};
#pragma unroll
            for (int j = 0; j < 8; ++j) { bt[j] = gg[j]; qv[j] = bf2f(q8[j]) * 0.17677669529663687f; kv[j] = bf2f(k8[j]); }
        } else { const float cs[8] = {rc0[0], rc0[1], rc0[2], rc0[3], rc1[0], rc1[1], rc1[2], rc1[3]}, sn[8] = {rs0[0], rs0[1], rs0[2], rs0[3], rs1[0], rs1[1], rs1[2], rs1[3]};
            const float lg = __logf(1.0f - exp2f(-5.0f - (float)h));
#pragma unroll
            for (int j = 0; j < 8; ++j) { const float a = bf2f(q8[j]), pq = bf2f(qp8[j]), bk = bf2f(k8[j]), pk = bf2f(kp8[j]);
                qv[j] = kg < 2 ? a * cs[j] - pq * sn[j] : pq * sn[j] + a * cs[j];
                kv[j] = (kg < 2 ? bk * cs[j] - pk * sn[j] : pk * sn[j] + bk * cs[j]) * 0.17677669529663687f; bt[j] = lg; }
        }
        const int tl = lane / NG;
#pragma unroll
        for (int d = 1; d < RPW; d <<= 1) {
#pragma unroll
            for (int j = 0; j < 8; ++j) { const float up = __shfl_up(bt[j], d * NG); if (tl >= d) bt[j] += up; } }
    }
    bsync();
    if (act && (lane / NG) == RPW - 1) { *(LAS f32x4*)(WT + wave * 64 + 8 * kg) = (f32x4){bt[0], bt[1], bt[2], bt[3]}; *(LAS f32x4*)(WT + wave * 64 + 8 * kg + 4) = (f32x4){bt[4], bt[5], bt[6], bt[7]}; }
    bsync();
    float Bv[4][8], bl[8];
    if (act) {
        float run[8];
#pragma unroll
        for (int j = 0; j < 8; ++j) { run[j] = 0.f; Bv[0][j] = 0.f; }
        float own[8];
#pragma unroll
        for (int j = 0; j < 8; ++j) own[j] = 0.f;
#pragma unroll
        for (int w2 = 0; w2 < NWV; ++w2) {
            if (w2 == wave) {
#pragma unroll
                for (int j = 0; j < 8; ++j) own[j] = run[j]; }
            if (w2 * RPW == 16) {
#pragma unroll
                for (int j = 0; j < 8; ++j) Bv[1][j] = run[j]; }
            if (w2 * RPW == 32) {
#pragma unroll
                for (int j = 0; j < 8; ++j) Bv[2][j] = run[j]; }
            if (w2 * RPW == 48) {
#pragma unroll
                for (int j = 0; j < 8; ++j) Bv[3][j] = run[j]; }
            const f32x4 w0 = *(const LAS f32x4*)(WT + w2 * 64 + 8 * kg), w1 = *(const LAS f32x4*)(WT + w2 * 64 + 8 * kg + 4);
            run[0] += w0[0]; run[1] += w0[1]; run[2] += w0[2]; run[3] += w0[3]; run[4] += w1[0]; run[5] += w1[1]; run[6] += w1[2]; run[7] += w1[3];
        }
#pragma unroll
        for (int j = 0; j < 8; ++j) { bl[j] = run[j]; bt[j] += own[j]; }
    }
    if (PH == 2) {
        if (act) {
#pragma unroll
            for (int j = 0; j < 8; ++j) KT[(8 * kg + j) * 72 + t] = (bf16)f2bf(kv[j] * __expf(bl[j] - bt[j]));
            if (t == 63) { float* dp = P_DEC + (size_t)(b * NCH + ch) * 512 + DOFF + h * DK + 8 * kg;
                *(f32x4*)dp = (f32x4){__expf(bl[0]), __expf(bl[1]), __expf(bl[2]), __expf(bl[3])}; *(f32x4*)(dp + 4) = (f32x4){__expf(bl[4]), __expf(bl[5]), __expf(bl[6]), __expf(bl[7])}; }
        }
#pragma unroll
        for (int j = 0; j < 8; ++j) VT[(8 * vg + j) * 72 + tv] = (bf16)vv[j];
        bsync();
        constexpr int NTL = (DK / 16) * 4;
        for (int T = wave; T < NTL; T += 8) { const int ki = T >> 2, vj = T & 3;
            const f32x4 d = tile16(KT + 16 * ki * 72, 72, VT + 16 * vj * 72, 72, 64, lane);
#pragma unroll
            for (int r = 0; r < 4; ++r) sl[(16 * ki + 4 * fq + r) * 64 + 16 * vj + fr] = d[r]; }
    } else {
        if (act) {
            const int it = t >> 4; float o8[8];
#pragma unroll
            for (int j = 0; j < 8; ++j) o8[j] = qv[j] * __expf(bt[j]);
            *(LAS u32x4*)(A1 + t * 136 + 8 * kg) = pack8(o8);
#pragma unroll
            for (int i = 0; i < 4; ++i) {
                if (i >= it) {
                    if (i == it) {
#pragma unroll
                        for (int j = 0; j < 8; ++j) o8[j] = qv[j] * __expf(bt[j] - Bv[i][j]);
                        *(LAS u32x4*)(QH + t * 72 + 8 * kg) = pack8(o8);
                    }
#pragma unroll
                    for (int j = 0; j < 8; ++j) o8[j] = kv[j] * __expf(fminf(Bv[i][j] - bt[j], 80.f));
                    *(LAS u32x4*)(KH + (8 * i * (i + 1) + t) * 72 + 8 * kg) = pack8(o8);
                }
            }
        }
#pragma unroll
        for (int j = 0; j < 8; ++j) B1[(8 * vg + j) * 136 + DK + tv] = (bf16)vv[j];
#pragma unroll
        for (int n = 0; n < NSP; ++n) { const int idx = 4 * (tid + 512 * n), k = idx >> 6, v = idx & 63;
#pragma unroll
            for (int j = 0; j < 4; ++j) B1[(v + j) * 136 + k] = (bf16)f2bf(P.sp4[n][j]); }
        bsync();
#pragma unroll
        for (int e = 0; e < 2; ++e) { const int T = 2 * wave + e, i = T >> 2, j = T & 3;
            f32x4 d = {0.f, 0.f, 0.f, 0.f};
            if (j <= i) d = tile16(QH + 16 * i * 72, 72, KH + (8 * i * (i + 1) + 16 * j) * 72, 72, DK, lane);
#pragma unroll
            for (int r = 0; r < 4; ++r) { const int tt = 4 * fq + r; const float val = (j < i || (j == i && fr <= tt)) ? d[r] : 0.f;
                A1[(16 * i + tt) * 136 + DK + 16 * j + fr] = (bf16)f2bf(val); } }
        bsync();
        f32x4 o[2];
#pragma unroll
        for (int e = 0; e < 2; ++e) o[e] = tile16T(A1 + 16 * ti * 136, 136, B1 + 16 * (vj0 + e) * 136, 136, KS, lane);
        float s1 = 0.f, s2 = 0.f;
#pragma unroll
        for (int e = 0; e < 2; ++e)
#pragma unroll
            for (int r = 0; r < 4; ++r) { s1 += o[e][r]; s2 += o[e][r] * o[e][r]; }
        s1 += __shfl_xor(s1, 16); s1 += __shfl_xor(s1, 32); s2 += __shfl_xor(s2, 16); s2 += __shfl_xor(s2, 32);
        if (fq == 0) *(LAS f32x2*)(PART + ((16 * ti + fr) * 2 + (wave & 1)) * 2) = (f32x2){s1, s2};
        bsync();
        {
            const f32x4 pp = *(const LAS f32x4*)(PART + (16 * ti + fr) * 4);
            const float S = pp[0] + pp[2], SS = pp[1] + pp[3];
            float mean = 0.f, var = SS * (1.0f / 64.0f);
            if (BR == 2) { mean = S * (1.0f / 64.0f); var -= mean * mean; }
            const float rstd = rsqrtf(fmaxf(var, 0.f) + EPS);
#pragma unroll
            for (int e = 0; e < 2; ++e) { float y[4];
#pragma unroll
                for (int r = 0; r < 4; ++r) y[r] = (o[e][r] - mean) * rstd * nw4[e][r] * siluf_(bf2f(P.z4[e][r]));
                u32x2 w; w.x = pk2(y[0], y[1]); w.y = pk2(y[2], y[3]);
                *(u32x2*)(P_MIX + (row0 + 16 * ti + fr) * 1024 + 256 * (BR + 1) + h * 64 + 16 * (vj0 + e) + 4 * fq) = w; }
        }
    }
}

__device__ __forceinline__ void cmul(float& xr, float& xi, float ar, float ai) { const float nr = xr * ar - xi * ai, ni = xr * ai + xi * ar; xr = nr; xi = ni; }
__device__ __forceinline__ void s5_p2(const Frame& F0, int l, int b, int ch) {
    const Frame F = fresh(F0);
    const int lane = F.lane, wave = F.wave, hh = lane >> 5, pl = lane & 31;
    const size_t row0 = (size_t)b * SEQ + (size_t)ch * CH;
    const bf16* proj = P_PROJ;
#pragma unroll 1
    for (int rd = 0; rd < 2; ++rd) {
        const int g = wave + 8 * rd;
        const bf16* bbt = P_BBT + (size_t)(l * 16 + g) * 128 * 16;
        bf16x8 au[2];
#pragma unroll
        for (int tt = 0; tt < 2; ++tt) au[tt] = *(const bf16x8*)(proj + (row0 + 32 * tt + pl) * NPROJ + C_S5U + 16 * g + 8 * hh);
        f32x4 avv[2]; bf16x8 brev[2], bimv[2];
#pragma unroll
        for (int np = 0; np < 2; ++np) { avv[np] = *(const f32x4*)(P_S5A + (size_t)((l * 16 + g) * 64 + 32 * np + pl) * 4);
            brev[np] = *(const bf16x8*)(bbt + (32 * np + pl) * 16 + 8 * hh); bimv[np] = *(const bf16x8*)(bbt + (64 + 32 * np + pl) * 16 + 8 * hh); }
#pragma unroll
        for (int np = 0; np < 2; ++np) {
            const f32x4 av = avv[np];
            const float a1r = av[0], a1i = av[1];
            float a4r = a1r, a4i = a1i; cmul(a4r, a4i, a4r, a4i); cmul(a4r, a4i, a4r, a4i);
            float a32r = a4r, a32i = a4i; cmul(a32r, a32i, a32r, a32i); cmul(a32r, a32i, a32r, a32i); cmul(a32r, a32i, a32r, a32i);
            const bf16x8 bre = brev[np], bim = bimv[np];
            float totr = 0.f, toti = 0.f;
#pragma unroll
            for (int tt = 0; tt < 2; ++tt) {
                f32x16 dre, dim;
#pragma unroll
                for (int i = 0; i < 16; ++i) { dre[i] = 0.f; dim[i] = 0.f; }
                dre = __builtin_amdgcn_mfma_f32_32x32x16_bf16(au[tt], bre, dre, 0, 0, 0);
                dim = __builtin_amdgcn_mfma_f32_32x32x16_bf16(au[tt], bim, dim, 0, 0, 0);
                float sr = 0.f, si = 0.f;
#pragma unroll
                for (int i = 0; i < 16; ++i) { if (i > 0 && (i & 3) == 0) cmul(sr, si, a4r, a4i); cmul(sr, si, a1r, a1i); sr += dre[i]; si += dim[i]; }
                if (hh == 0) cmul(sr, si, a4r, a4i);
                sr += __shfl_xor(sr, 32); si += __shfl_xor(si, 32);
                cmul(totr, toti, a32r, a32i); totr += sr; toti += si;
            }
            if (hh == 0) *(f32x2*)(P_S5LOC + ((size_t)(b * NCH + ch) * 16 + g) * 128 + 2 * (32 * np + pl)) = (f32x2){totr, toti};
        }
    }
}
__device__ __forceinline__ int s5dw(int t, int p) { return t * 64 + ((((p >> 2) ^ (t & 7))) << 2) + (p & 3); }
__device__ __forceinline__ void s5_p4(const Frame& F0, int l, int b, int ch) {
    const Frame F = fresh(F0);
    LAS unsigned char* L = F.lds;
    const int lane = F.lane, wave = F.wave, hh = lane >> 5, pl = lane & 31, fr = lane & 15, fq = lane >> 4;
    LAS unsigned* SD = (LAS unsigned*)(L + wave * 16384);
    const size_t row0 = (size_t)b * SEQ + (size_t)ch * CH;
    const bf16* proj = P_PROJ;
    bsync();
    f32x4 yacc[2][4];
#pragma unroll
    for (int rd = 0; rd < 2; ++rd) {
        const int g = wave + 8 * rd;
        const bf16* bbt = P_BBT + (size_t)(l * 16 + g) * 128 * 16;
        const bf16* ccn = P_CCN + (size_t)(l * 16 + g) * 16 * 128;
        bf16x8 au[2], brev[2], bimv[2], bfr[4];
#pragma unroll
        for (int tt = 0; tt < 2; ++tt) au[tt] = *(const bf16x8*)(proj + (row0 + 32 * tt + pl) * NPROJ + C_S5U + 16 * g + 8 * hh);
#pragma unroll
        for (int np = 0; np < 2; ++np) { brev[np] = *(const bf16x8*)(bbt + (32 * np + pl) * 16 + 8 * hh); bimv[np] = *(const bf16x8*)(bbt + (64 + 32 * np + pl) * 16 + 8 * hh); }
        const f32x4 av = *(const f32x4*)(P_S5A + (size_t)((l * 16 + g) * 64 + lane) * 4);
        const f32x2 sp0 = *(const f32x2*)(P_S5LOC + ((size_t)(b * NCH + ch) * 16 + g) * 128 + 2 * lane);
#pragma unroll
        for (int ks = 0; ks < 4; ++ks) bfr[ks] = *(const bf16x8*)(ccn + fr * 128 + 32 * ks + 8 * fq);
#pragma unroll
        for (int tt = 0; tt < 2; ++tt)
#pragma unroll
            for (int np = 0; np < 2; ++np) {
                f32x16 dre, dim;
#pragma unroll
                for (int i = 0; i < 16; ++i) { dre[i] = 0.f; dim[i] = 0.f; }
                dre = __builtin_amdgcn_mfma_f32_32x32x16_bf16(au[tt], brev[np], dre, 0, 0, 0);
                dim = __builtin_amdgcn_mfma_f32_32x32x16_bf16(au[tt], bimv[np], dim, 0, 0, 0);
#pragma unroll
                for (int i = 0; i < 16; ++i) { const int tr = 32 * tt + (i & 3) + 8 * (i >> 2) + 4 * hh; SD[s5dw(tr, 32 * np + pl)] = pk2(dre[i], dim[i]); }
            }
        LDS_WAIT();
        {
            const float ar = av[0], ai = av[1]; float sr = sp0[0], si = sp0[1];
            for (int t0 = 0; t0 < 64; t0 += 8) {
                unsigned wv[8];
#pragma unroll
                for (int u = 0; u < 8; ++u) wv[u] = SD[s5dw(t0 + u, lane)];
#pragma unroll
                for (int u = 0; u < 8; ++u) { const float br = __builtin_bit_cast(float, wv[u] << 16), bi = __builtin_bit_cast(float, wv[u] & 0xffff0000u);
                    const float nr = __builtin_fmaf(ar, sr, __builtin_fmaf(-ai, si, br)), ni = __builtin_fmaf(ar, si, __builtin_fmaf(ai, sr, bi)); sr = nr; si = ni; wv[u] = pk2(nr, ni); }
#pragma unroll
                for (int u = 0; u < 8; ++u) SD[s5dw(t0 + u, lane)] = wv[u];
            }
        }
        LDS_WAIT();
#pragma unroll
        for (int ti = 0; ti < 4; ++ti) { f32x4 acc = {0.f, 0.f, 0.f, 0.f};
#pragma unroll
            for (int ks = 0; ks < 4; ++ks) { const bf16x8 afr = *(const LAS bf16x8*)(SD + s5dw(16 * ti + fr, 16 * ks + 4 * fq));
                acc = __builtin_amdgcn_mfma_f32_16x16x32_bf16(bfr[ks], afr, acc, 0, 0, 0); }
            yacc[rd][ti] = acc; }
        LDS_WAIT();
    }
    bsync();
    LAS bf16* YB = (LAS bf16*)L;
#pragma unroll
    for (int rd = 0; rd < 2; ++rd) { const int g = wave + 8 * rd;
#pragma unroll
        for (int ti = 0; ti < 4; ++ti) { const int t = 16 * ti + fr, c0 = 16 * g + 4 * fq;
            const bf16x4 u4 = *(const bf16x4*)(proj + (row0 + t) * NPROJ + C_S5U + c0);
            const f32x4 dsk = *(const f32x4*)(INP(I_S5D) + l * 256 + c0);
            float y[4];
#pragma unroll
            for (int j = 0; j < 4; ++j) y[j] = gelu_tanh(yacc[rd][ti][j] + dsk[j] * bf2f(u4[j]));
            u32x2 w; w.x = pk2(y[0], y[1]); w.y = pk2(y[2], y[3]);
            *(LAS u32x2*)(YB + t * 264 + c0) = w; } }
    bsync();
    const bf16* wg = P_WGLU + (size_t)l * 256 * 256;
#pragma unroll
    for (int nt = 0; nt < 2; ++nt) { const int ntile = 2 * wave + nt;
        f32x4 acc[4];
#pragma unroll
        for (int ti = 0; ti < 4; ++ti) acc[ti] = (f32x4){0.f, 0.f, 0.f, 0.f};
        bf16x8 bw[8];
#pragma unroll
        for (int ks = 0; ks < 8; ++ks) bw[ks] = *(const bf16x8*)(wg + (size_t)(16 * ntile + fr) * 256 + 32 * ks + 8 * fq);
#pragma unroll
        for (int ks = 0; ks < 8; ++ks) {
#pragma unroll
            for (int ti = 0; ti < 4; ++ti) { const bf16x8 afr = *(const LAS bf16x8*)(YB + (16 * ti + fr) * 264 + 32 * ks + 8 * fq);
                acc[ti] = __builtin_amdgcn_mfma_f32_16x16x32_bf16(bw[ks], afr, acc[ti], 0, 0, 0); }
        }
#pragma unroll
        for (int ti = 0; ti < 4; ++ti) {
            const int t = 16 * ti + fr, n0 = 16 * ntile + 4 * fq;
            const bf16x4 y4 = *(const LAS bf16x4*)(YB + t * 264 + n0);
            const bf16x4 z4 = *(const bf16x4*)(proj + (row0 + t) * NPROJ + C_S5Z + n0);
            float o[4];
#pragma unroll
            for (int j = 0; j < 4; ++j) o[j] = bf2f(y4[j]) * sigmoidf_(acc[ti][j]) * siluf_(bf2f(z4[j]));
            u32x2 w; w.x = pk2(o[0], o[1]); w.y = pk2(o[2], o[3]);
            *(u32x2*)(P_MIX + (row0 + t) * 1024 + n0) = w; } }
}

__device__ __forceinline__ void p3_carry(const Frame& F0, int l) {
    const Frame F = fresh(F0);
    const int gt = F.bid * 512 + F.tid, NGT = F.G * 512;
    for (int e = gt; e < NBATCH * 32768; e += NGT) {
        const int b = e >> 15, r = e & 32767;
        int di; size_t oo;
        if (r < 16384) { di = r >> 6; oo = O_HG_P + (size_t)(l * 8 + b) * 16384 + r; }
        else if (r < 24576) { di = 256 + ((r - 16384) >> 6); oo = O_GLA_P + (size_t)(l * 8 + b) * 8192 + (r - 16384); }
        else { di = 384 + ((r - 24576) >> 6); oo = O_RET_P + (size_t)(l * 8 + b) * 8192 + (r - 24576); }
        float* sp = P_SLOC + (size_t)b * NCH * 32768 + r; const float* dp = P_DEC + (size_t)b * NCH * 512 + di;
        float S = 0.f;
        for (int c0 = 0; c0 < NCH; c0 += 16) {
            float hv[16], dv[16];
#pragma unroll
            for (int c = 0; c < 16; ++c) { hv[c] = sp[(size_t)(c0 + c) * 32768]; dv[c] = dp[(size_t)(c0 + c) * 512]; }
#pragma unroll
            for (int c = 0; c < 16; ++c) { sp[(size_t)(c0 + c) * 32768] = S; S = dv[c] * S + hv[c]; }
        }
        OUTP[oo] = S;
    }
    for (int e = gt; e < NBATCH * 1024; e += NGT) {
        const int b = e >> 10, gp = e & 1023;
        const f32x4 av = *(const f32x4*)(P_S5A + (size_t)(l * 1024 + gp) * 4); const float a64r = av[2], a64i = av[3];
        float* sp = P_S5LOC + (size_t)b * NCH * 2048 + 2 * gp;
        float sr = 0.f, si = 0.f;
        for (int c = 0; c < NCH; ++c) { const f32x2 hv = *(const f32x2*)(sp + (size_t)c * 2048); *(f32x2*)(sp + (size_t)c * 2048) = (f32x2){sr, si};
            const float nr = a64r * sr - a64i * si + hv[0], ni = a64r * si + a64i * sr + hv[1]; sr = nr; si = ni; }
        OUTP[O_S5RE_P + (size_t)(l * 8 + b) * 1024 + gp] = sr; OUTP[O_S5IM_P + (size_t)(l * 8 + b) * 1024 + gp] = si;
    }
}

template <int BR>
__device__ __forceinline__ void samp_branch_item(const Frame& F0, int l, int sb) {
    const Frame F = fresh(F0);
    constexpr int DK = (BR == 0) ? 64 : 32, NR = 4 * DK, RPS = NR / 8;
    constexpr int QOFF = BR == 0 ? C_HGQ : (BR == 1 ? C_GLQ : C_RTQ), KOFF = BR == 0 ? C_HGF : (BR == 1 ? C_GLK : C_RTK), VOFF = BR == 0 ? C_HGI : (BR == 1 ? C_GLV : C_RTV), ZOFF = BR == 0 ? C_HGZ : (BR == 1 ? C_GLZ : C_RTZ);
    LAS float* QS = (LAS float*)(F.lds + 0);
    LAS float* KSV = (LAS float*)(F.lds + 1024);
    LAS float* EG = (LAS float*)(F.lds + 2048);
    LAS float* VS = (LAS float*)(F.lds + 3072);
    LAS float* PART = (LAS float*)(F.lds + 4096);
    const int tid = F.tid;
    const bf16* pr = P_PROJ + (size_t)(TP + sb) * NPROJ;
    const int v = tid & 63, ksl = tid >> 6;
    const size_t sbase = (size_t)(l * NS + sb) * NR * 64;
    const float* s0 = INP(BR == 0 ? I_SHG : (BR == 1 ? I_SGLA : I_SRET)) + sbase + (size_t)ksl * RPS * 64 + v;
    float* s1 = OUTP + (BR == 0 ? O_HG_S : (BR == 1 ? O_GLA_S : O_RET_S)) + sbase + (size_t)ksl * RPS * 64 + v;
    float sv[RPS];
#pragma unroll
    for (int kk = 0; kk < RPS; ++kk) sv[kk] = s0[kk * 64];
    bsync();
    if (tid < NR) {
        const int c = tid;
        if (BR == 0) { const float x = bf2f((short)pr[KOFF + c]), lb = P_LB[l * 256 + c], e = __expf(-x), sg = rcpf_(1.0f + e);
            EG[c] = lb + (1.0f - lb) * sg; KSV[c] = (1.0f - lb) * e * sg; QS[c] = bf2f((short)pr[QOFF + c]); }
        else if (BR == 1) { EG[c] = __expf(P_GG[(size_t)(TP + sb) * 128 + c]); QS[c] = bf2f((short)pr[QOFF + c]) * 0.17677669529663687f; KSV[c] = bf2f((short)pr[KOFF + c]); }
        else { const int h = c >> 5, kq = c & 31, j = kq & 15; const float cs = P_ROT[2048 * 16 + j], sn = P_ROT[2049 * 16 + 2048 * 16 + j];
            const float q1 = bf2f((short)pr[QOFF + h * 32 + j]), q2 = bf2f((short)pr[QOFF + h * 32 + 16 + j]), k1 = bf2f((short)pr[KOFF + h * 32 + j]), k2 = bf2f((short)pr[KOFF + h * 32 + 16 + j]);
            QS[c] = kq < 16 ? q1 * cs - q2 * sn : q1 * sn + q2 * cs; KSV[c] = (kq < 16 ? k1 * cs - k2 * sn : k1 * sn + k2 * cs) * 0.17677669529663687f;
            EG[c] = 1.0f - exp2f(-5.0f - (float)h); }
    }
    if (tid >= 256) VS[tid - 256] = bf2f((short)pr[VOFF + (tid - 256)]);
    bsync();
    {
        const int hh = (ksl * RPS) / DK; const float vvv = VS[hh * 64 + v]; float acc = 0.f;
#pragma unroll
        for (int kk = 0; kk < RPS; ++kk) { const int c = ksl * RPS + kk; const float sn = EG[c] * sv[kk] + KSV[c] * vvv; s1[kk * 64] = sn; acc += QS[c] * sn; }
        PART[ksl * 64 + v] = acc;
    }
    bsync();
    if (tid < 256) {
        const int h = tid >> 6;
        float o = PART[(2 * h) * 64 + v] + PART[(2 * h + 1) * 64 + v];
        if (BR == 2) o -= wave_sum(o) * (1.0f / 64.0f);
        const float rstd = rsqrtf(wave_sum(o * o) * (1.0f / 64.0f) + EPS);
        const float nw = INP(BR == 0 ? I_HGNW : (BR == 1 ? I_GLNW : I_RTNW))[l * 256 + tid];
        const float z = bf2f((short)pr[ZOFF + tid]);
        P_MIX[(size_t)(TP + sb) * 1024 + 256 * (BR + 1) + tid] = (bf16)f2bf(o * rstd * nw * siluf_(z));
    }
}
__device__ __forceinline__ void samp_s5_item(const Frame& F0, int l, int sb) {
    const Frame F = fresh(F0);
    LAS float* US = (LAS float*)(F.lds + 0);
    LAS float* SS = (LAS float*)(F.lds + 1024);
    LAS float* YS = (LAS float*)(F.lds + 1024 + 8192);
    const int tid = F.tid;
    const bf16* pr = P_PROJ + (size_t)(TP + sb) * NPROJ;
    bsync();
    if (tid < 256) US[tid] = bf2f((short)pr[C_S5U + tid]);
    bsync();
    for (int idx = tid; idx < 1024; idx += 512) { const int g = idx >> 6, p = idx & 63;
        const bf16* bb = P_BBT + (size_t)(l * 16 + g) * 128 * 16; float br = 0.f, bi = 0.f;
#pragma unroll
        for (int c = 0; c < 16; ++c) { const float u = US[16 * g + c]; br += bf2f((short)bb[p * 16 + c]) * u; bi += bf2f((short)bb[(64 + p) * 16 + c]) * u; }
        const f32x4 av = *(const f32x4*)(P_S5A + (size_t)(l * 1024 + idx) * 4);
        const size_t si = (size_t)(l * NS + sb) * 1024 + idx;
        const float s0r = INP(I_S5RE)[si], s0i = INP(I_S5IM)[si];
        const float nr = av[0] * s0r - av[1] * s0i + br, ni = av[0] * s0i + av[1] * s0r + bi;
        OUTP[O_S5RE_S + si] = nr; OUTP[O_S5IM_S + si] = ni; SS[g * 128 + 2 * p] = nr; SS[g * 128 + 2 * p + 1] = ni; }
    bsync();
    if (tid < 256) { const int g = tid >> 4, c = tid & 15; const bf16* cc = P_CCN + (size_t)(l * 16 + g) * 16 * 128 + c * 128; float y = 0.f;
        for (int n = 0; n < 128; ++n) y += bf2f((short)cc[n]) * SS[g * 128 + n];
        YS[tid] = gelu_tanh(y + INP(I_S5D)[l * 256 + tid] * US[tid]); }
    bsync();
    if (tid < 256) { const bf16* wg = P_WGLU + (size_t)l * 256 * 256 + (size_t)tid * 256; float gl = 0.f;
        for (int c8 = 0; c8 < 32; ++c8) { const bf16x8 w = *(const bf16x8*)(wg + 8 * c8);
#pragma unroll
            for (int j = 0; j < 8; ++j) gl += bf2f(w[j]) * YS[8 * c8 + j]; }
        const float z = bf2f((short)pr[C_S5Z + tid]);
        P_MIX[(size_t)(TP + sb) * 1024 + tid] = (bf16)f2bf(YS[tid] * sigmoidf_(gl) * siluf_(z)); }
}

__device__ __forceinline__ void final_norm(const Frame& F0) {
    const Frame F = fresh(F0);
    const int gw = F.bid * NWAVES + F.wave, NGW = F.G * NWAVES, lane = F.lane;
    for (int m = gw; m < TT; m += NGW) {
        float* row = m < TP ? OUTP + O_YP + (size_t)m * DM : OUTP + O_YS + (size_t)(m - TP) * DM;
        f32x4* xr = (f32x4*)row + lane; f32x4 v[4]; float s = 0.f;
#pragma unroll
        for (int j = 0; j < 4; ++j) { v[j] = xr[64 * j]; s += (v[j][0] * v[j][0] + v[j][1] * v[j][1]) + (v[j][2] * v[j][2] + v[j][3] * v[j][3]); }
        const float rstd = 1.0f / sqrtf(wave_sum(s) * (1.0f / 1024.0f) + EPS);
        const f32x4* wr = (const f32x4*)INP(I_FNORMW) + lane;
#pragma unroll
        for (int j = 0; j < 4; ++j) xr[64 * j] = v[j] * rstd * wr[64 * j];
    }
}

__global__ void __launch_bounds__(NWAVES * 64, 2) __attribute__((target("no-packed-fp32-ops"))) mk_fwd(Args args) {
    extern __shared__ __attribute__((aligned(16))) unsigned char lds[];
    Frame F;
    F.lds = (LAS unsigned char*)lds;
    F.tid = threadIdx.x; F.lane = F.tid & 63; F.wave = __builtin_amdgcn_readfirstlane(F.tid >> 6); F.G = gridDim.x; F.bid = blockIdx.x; F.kp = (KargPtr)__builtin_amdgcn_kernarg_segment_ptr();
    unsigned char* ws = args.ws;
    volatile LAS unsigned* MISC = (volatile LAS unsigned*)(F.lds + MISC_OFF);
    for (int u = F.tid; u < (LDS_BYTES - LDSCTL_OFF) / 4; u += NWAVES * 64) ((LAS unsigned*)(F.lds + LDSCTL_OFF))[u] = 0u;
    bsync();
    unsigned* barw = (unsigned*)(ws + WS_CTL) + CW_BAR;
    XcdBarrier bar; bar.bar = barw; bar.x = 0; bar.st = nullptr;
    if (N_LAUNCHES == 1) bar = xcd_barrier_post(barw, MISC + 8);
    const int lo = args.ph_lo, hi = args.ph_hi;
#define IN(k) (lo <= (k) && (k) < hi)
#define SEAM(k) do { if (IN(k) && IN((k) + 1)) xcd_barrier(bar); } while (0)

    if (IN(0)) { p0_prologue(F, 7); if ((DUP_MASK) >> 7) p0_prologue(F, (DUP_MASK) >> 7); }
    SEAM(0);
#pragma unroll 1
    for (int l = 0; l < 2; ++l) {
        const int pb = 1 + 5 * l;
        if (IN(pb)) {
            pg8::Gemm g{P_XB, P_WIN + (size_t)l * NPROJ * 1024, TP, NPROJ, DM}; pg8::StaticOrder S; S.init(TP, NPROJ, F.G, F.bid);
            pg8::EpiProj E{P_PROJ, P_ROWSS};
            for (int rep = 0; rep < NREP(1); ++rep) pg8::gemm_phase<pg8::EpiProj, pg8::StaticOrder, true, true>(F.lds, g, S, E);
            for (int rep = 0; rep < NREP(5); ++rep) for (int u = F.bid; u < N_G1_SMALL; u += F.G) g1_small_unit(F, l, u);
        }
        SEAM(pb);
        if (IN(pb + 1)) {
            for (int rep = 0; rep < NREP(2); ++rep)
            for (int it = F.bid; it < NBC; it += F.G) { const int b = it / NCH, ch = it % NCH;
                p2_chunk_gates(F, l, b, ch);
                { AttPre A{}, B{};
                att_prefetch<0, 2>(F, l, b, ch, 0, A);
#pragma unroll 1
                for (int hp = 0; hp < 2; ++hp) { att_prefetch<0, 2>(F, l, b, ch, 2 * hp + 1, B); att_item<0, 2>(F, l, b, ch, 2 * hp, A);
                    if (hp == 0) att_prefetch<0, 2>(F, l, b, ch, 2, A); else att_prefetch<1, 2>(F, l, b, ch, 0, A); att_item<0, 2>(F, l, b, ch, 2 * hp + 1, B); }
#pragma unroll 1
                for (int hp = 0; hp < 2; ++hp) { att_prefetch<1, 2>(F, l, b, ch, 2 * hp + 1, B); att_item<1, 2>(F, l, b, ch, 2 * hp, A);
                    if (hp == 0) att_prefetch<1, 2>(F, l, b, ch, 2, A); else att_prefetch<2, 2>(F, l, b, ch, 0, A); att_item<1, 2>(F, l, b, ch, 2 * hp + 1, B); }
#pragma unroll 1
                for (int hp = 0; hp < 2; ++hp) { att_prefetch<2, 2>(F, l, b, ch, 2 * hp + 1, B); att_item<2, 2>(F, l, b, ch, 2 * hp, A);
                    if (hp == 0) att_prefetch<2, 2>(F, l, b, ch, 2, A); att_item<2, 2>(F, l, b, ch, 2 * hp + 1, B); }
                }
                s5_p2(F, l, b, ch); }
        }
        SEAM(pb + 1);
        if (IN(pb + 2)) p3_carry(F, l);
        SEAM(pb + 2);
        if (IN(pb + 3)) {
            for (int rep = 0; rep < NREP(3); ++rep)
            for (int it = F.bid; it < NBC; it += F.G) { const int b = it / NCH, ch = it % NCH;
                { AttPre A{}, B{};
                att_prefetch<0, 4>(F, l, b, ch, 0, A);
#pragma unroll 1
                for (int hp = 0; hp < 2; ++hp) { att_prefetch<0, 4>(F, l, b, ch, 2 * hp + 1, B); att_item<0, 4>(F, l, b, ch, 2 * hp, A);
                    if (hp == 0) att_prefetch<0, 4>(F, l, b, ch, 2, A); else att_prefetch<1, 4>(F, l, b, ch, 0, A); att_item<0, 4>(F, l, b, ch, 2 * hp + 1, B); }
#pragma unroll 1
                for (int hp = 0; hp < 2; ++hp) { att_prefetch<1, 4>(F, l, b, ch, 2 * hp + 1, B); att_item<1, 4>(F, l, b, ch, 2 * hp, A);
                    if (hp == 0) att_prefetch<1, 4>(F, l, b, ch, 2, A); else att_prefetch<2, 4>(F, l, b, ch, 0, A); att_item<1, 4>(F, l, b, ch, 2 * hp + 1, B); }
#pragma unroll 1
                for (int hp = 0; hp < 2; ++hp) { att_prefetch<2, 4>(F, l, b, ch, 2 * hp + 1, B); att_item<2, 4>(F, l, b, ch, 2 * hp, A);
                    if (hp == 0) att_prefetch<2, 4>(F, l, b, ch, 2, A); att_item<2, 4>(F, l, b, ch, 2 * hp + 1, B); }
                }
                s5_p4(F, l, b, ch); }
            for (int rep = 0; rep < NREP(6); ++rep)
            for (int it = F.bid; it < NS * 4; it += F.G) { const int sb = it >> 2, sub = (it + 2 * (it >> 8)) & 3;
                if (sub == 0) samp_branch_item<0>(F, l, sb); else if (sub == 1) samp_branch_item<1>(F, l, sb); else if (sub == 2) samp_branch_item<2>(F, l, sb); else samp_s5_item(F, l, sb); }
        }
        SEAM(pb + 3);
        if (IN(pb + 4)) {
            pg8::Gemm g{P_MIX, P_WOUT + (size_t)l * 1024 * 1024, TP, DM, DM}; pg8::StaticOrder S; S.init(TP, DM, F.G, F.bid);
            pg8::EpiRes E{l == 0 ? INP(I_XP) : OUTP + O_YP, OUTP + O_YP, l == 0 ? P_XB : nullptr, P_ROWSS};
            for (int rep = 0; rep < (l == 0 ? NREP(4) : 1); ++rep) pg8::gemm_phase<pg8::EpiRes, pg8::StaticOrder, false, true>(F.lds, g, S, E);
            for (int u = F.bid; u < N_G2_SMALL; u += F.G) g2_small_unit(F, l, u);
        }
        SEAM(pb + 4);
    }
    if (IN(11)) final_norm(F);
#undef IN
#undef SEAM
}

extern "C" void kernel_launch(void* const* d_in, const int* in_sizes, int n_in, void* d_out, int out_size, void* d_ws, size_t ws_size, hipStream_t stream) {
    static int grid = 0;
    if (grid == 0) {
        if (n_in != N_INPUTS || in_sizes[0] != TP * DM || (size_t)out_size != O_END || ws_size < WS_END) { fprintf(stderr, "kernel_launch: unexpected shapes (n_in %d, in0 %d, out %d, ws %zu)\n", n_in, n_in > 0 ? in_sizes[0] : -1, out_size, ws_size); grid = -1; return; }
        int dev = 0, cus = 0, per_cu = 0;
        if (hipGetDevice(&dev) != hipSuccess || hipDeviceGetAttribute(&cus, hipDeviceAttributeMultiprocessorCount, dev) != hipSuccess) { grid = -1; return; }
        if (hipFuncSetAttribute((const void*)mk_fwd, hipFuncAttributeMaxDynamicSharedMemorySize, LDS_BYTES) != hipSuccess) { fprintf(stderr, "kernel_launch: hipFuncSetAttribute failed\n"); grid = -1; return; }
        if (hipOccupancyMaxActiveBlocksPerMultiprocessor(&per_cu, (const void*)mk_fwd, NWAVES * 64, LDS_BYTES) != hipSuccess || per_cu < 1) fprintf(stderr, "kernel_launch: occupancy query says %d\n", per_cu);
        (void)hipGetLastError();
        grid = cus < 256 ? cus : 256;
    }
    if (grid < 0) return;
    if (hipMemsetAsync((char*)d_ws + WS_CTL, 0, CTL_ZERO_BYTES, stream) != hipSuccess) return;
    Args a{};
    for (int i = 0; i < N_INPUTS; ++i) a.in[i] = (const float*)d_in[i];
    a.out = (float*)d_out; a.ws = (unsigned char*)d_ws;
    for (int li = 0; li < N_LAUNCHES; ++li) {
        a.ph_lo = (N_LAUNCHES == 1) ? 0 : li; a.ph_hi = (N_LAUNCHES == 1) ? N_PHASES : li + 1; a.li = li;
        hipLaunchKernelGGL(mk_fwd, dim3(grid), dim3(NWAVES * 64), LDS_BYTES, stream, a);
    }
}
```
